# Optimizing an MI355X kernel written in HIP

```python
import jax, jax.numpy as jnp
from jax import lax
import numpy as np

D_MODEL = 2048
BATCH = 32
SEQ = 256
DEPTH = 4
DEC_BATCH = 8
DEC_SEQ = 1024
PAST_LEN = 256

GRID_W = 64
HEAD_DIM = 128
H_A = 6
H_B = 6
KV_B = 2
REP_B = H_B // KV_B
G_C = 4
C_GROUP = 128
W_A = H_A * HEAD_DIM
W_B = H_B * HEAD_DIM
W_C = G_C * C_GROUP
MIX_WIDTH = W_A + W_B + W_C
NA_ROWS = 8
NA_COLS = 16
WIN = 128
BLK = 128
CHUNK = 128
D_FF = -(-8 * D_MODEL // (3 * 256)) * 256
N_MOD = 6
ROPE_BASE = 10000.0
NORM_EPS = 1e-6
ATTN_SCALE = HEAD_DIM ** -0.5
Q_A = 0
K_A = Q_A + W_A
V_A = K_A + W_A
Q_B = V_A + W_A
K_B = Q_B + W_B
V_B = K_B + KV_B * HEAD_DIM
U_C = V_B + KV_B * HEAD_DIM
V_C = U_C + W_C
IN_WIDTH = V_C + W_C

kernel_name = 'hybrid_prefix_diffusion_step'


def rms_norm(x, g):
    x32 = x.astype(jnp.float32)
    y = x32 * lax.rsqrt(jnp.mean(x32 * x32, axis=-1, keepdims=True) + NORM_EPS)
    return (y * g.astype(jnp.float32)).astype(x.dtype)


def layer_norm(x, g, b):
    x32 = x.astype(jnp.float32)
    mu = jnp.mean(x32, axis=-1, keepdims=True)
    xc = x32 - mu
    y = xc * lax.rsqrt(jnp.mean(xc * xc, axis=-1, keepdims=True) + NORM_EPS)
    return (y * g.astype(jnp.float32) + b.astype(jnp.float32)).astype(x.dtype)


def rope_1d(x, pos):
    half = x.shape[-1] // 2
    freqs = ROPE_BASE ** (-jnp.arange(half, dtype=jnp.float32) / half)
    ang = pos.astype(jnp.float32)[:, None] * freqs[None, :]
    cos, sin = jnp.cos(ang), jnp.sin(ang)
    x32 = x.astype(jnp.float32)
    x1, x2 = x32[..., :half], x32[..., half:]
    return jnp.concatenate([x1 * cos - x2 * sin, x1 * sin + x2 * cos], axis=-1).astype(x.dtype)


def axial_rope(x):
    n = x.shape[-2]
    t = jnp.arange(n)
    half = x.shape[-1] // 2
    return jnp.concatenate([rope_1d(x[..., :half], t // GRID_W),
                            rope_1d(x[..., half:], t % GRID_W)], axis=-1)


def modulation(cond, w_mod, b_mod):
    m = jax.nn.silu(cond) @ w_mod + b_mod
    return jnp.split(m[..., None, :], N_MOD, axis=-1)


def split_projection(h, w_in):
    z = h @ w_in
    b, L, _ = z.shape
    def heads(a, nh):
        return a.reshape(b, L, nh, HEAD_DIM).transpose(0, 2, 1, 3)
    q_a = heads(z[..., Q_A:K_A], H_A)
    k_a = heads(z[..., K_A:V_A], H_A)
    v_a = heads(z[..., V_A:Q_B], H_A)
    q_b = z[..., Q_B:K_B].reshape(b, L, KV_B, REP_B, HEAD_DIM).transpose(0, 2, 3, 1, 4)
    k_b = heads(z[..., K_B:V_B], KV_B)
    v_b = heads(z[..., V_B:U_C], KV_B)
    u_c = jax.nn.gelu(z[..., U_C:V_C])
    v_c = jax.nn.gelu(z[..., V_C:IN_WIDTH])
    return q_a, k_a, v_a, q_b, k_b, v_b, u_c, v_c


def merge_heads(o_a, o_b, o_c, w_out):
    b, _, L, _ = o_a.shape
    o_a = o_a.transpose(0, 2, 1, 3).reshape(b, L, W_A)
    o_b = o_b.transpose(0, 3, 1, 2, 4).reshape(b, L, W_B)
    return jnp.concatenate([o_a, o_b, o_c], axis=-1) @ w_out


def context_attention(q, k, v, sink):
    b, g, r, s, d = q.shape
    nq = s // BLK
    qb = jnp.moveaxis(q.reshape(b, g, r, nq, BLK, d), 3, 0)
    def block(qi):
        sc = jnp.einsum('bgrqd,bgkd->bgrqk', qi, k).astype(jnp.float32) * ATTN_SCALE
        if sink is not None:
            sk = jnp.broadcast_to(sink.astype(jnp.float32)[None, :, :, None, None], (b, g, r, BLK, 1))
            sc = jnp.concatenate([sc, sk], axis=-1)
        p = jax.nn.softmax(sc, axis=-1)[..., :s].astype(v.dtype)
        return jnp.einsum('bgrqk,bgkd->bgrqd', p, v)
    out = lax.map(block, qb)
    return jnp.moveaxis(out, 0, 3).reshape(b, g, r, s, d)


def neighbourhood_attention(q, k, v, ck, cv, rpb):
    b, h, n, d = q.shape
    rows = n // GRID_W
    kr = min(NA_ROWS, rows)
    r = jnp.arange(rows)
    row_idx = jnp.clip(r - kr // 2, 0, rows - kr)[:, None] + jnp.arange(kr)[None, :]
    col = jnp.arange(GRID_W)
    c0 = jnp.clip(col - NA_COLS // 2, 0, GRID_W - NA_COLS)
    col_ok = (col[None, :] >= c0[:, None]) & (col[None, :] < c0[:, None] + NA_COLS)
    idx_r = row_idx - r[:, None] + NA_ROWS - 1
    idx_c = jnp.clip(col[None, :] - col[:, None] + NA_COLS - 1, 0, 2 * NA_COLS - 2)
    bias = rpb[:, idx_r[:, None, :, None], idx_c[None, :, None, :]].astype(jnp.float32)
    q5 = q.reshape(b, h, rows, GRID_W, d)
    k_band = k.reshape(b, h, rows, GRID_W, d)[:, :, row_idx]
    v_band = v.reshape(b, h, rows, GRID_W, d)[:, :, row_idx]
    s_loc = jnp.einsum('bhrqd,bhrjkd->bhrqjk', q5, k_band).astype(jnp.float32) * ATTN_SCALE + bias[None]
    s_loc = jnp.where(col_ok[:, None, :], s_loc, -jnp.inf).reshape(b, h, rows, GRID_W, kr * GRID_W)
    s_ctx = jnp.einsum('bhrqd,bhsd->bhrqs', q5, ck).astype(jnp.float32) * ATTN_SCALE
    p = jax.nn.softmax(jnp.concatenate([s_loc, s_ctx], axis=-1), axis=-1).astype(v.dtype)
    p_loc = p[..., :kr * GRID_W].reshape(b, h, rows, GRID_W, kr, GRID_W)
    p_ctx = p[..., kr * GRID_W:]
    out = (jnp.einsum('bhrqjk,bhrjkd->bhrqd', p_loc, v_band)
           + jnp.einsum('bhrqs,bhsd->bhrqd', p_ctx, cv))
    return out.reshape(b, h, n, d)


def window_attention(q, k, v, ck, cv, sink):
    b, g, r, n, d = q.shape
    nb = n // BLK
    span = BLK + 2 * WIN
    pad = ((0, 0), (0, 0), (WIN, WIN), (0, 0))
    kp, vp = jnp.pad(k, pad), jnp.pad(v, pad)
    idx = (jnp.arange(nb) * BLK)[:, None] + jnp.arange(span)[None, :]
    kb, vb = kp[:, :, idx], vp[:, :, idx]
    qb = q.reshape(b, g, r, nb, BLK, d)
    qpos = jnp.arange(n).reshape(nb, BLK)
    kpos = idx - WIN
    ok = ((jnp.abs(qpos[:, :, None] - kpos[:, None, :]) <= WIN)
          & (kpos[:, None, :] >= 0) & (kpos[:, None, :] < n))
    s_loc = jnp.einsum('bgrnqd,bgnkd->bgrnqk', qb, kb).astype(jnp.float32) * ATTN_SCALE
    s_loc = jnp.where(ok, s_loc, -jnp.inf)
    s_ctx = jnp.einsum('bgrnqd,bgsd->bgrnqs', qb, ck).astype(jnp.float32) * ATTN_SCALE
    sk = jnp.broadcast_to(sink.astype(jnp.float32)[None, :, :, None, None, None], (b, g, r, nb, BLK, 1))
    p = jax.nn.softmax(jnp.concatenate([s_loc, s_ctx, sk], axis=-1), axis=-1).astype(v.dtype)
    sc = ck.shape[2]
    out = (jnp.einsum('bgrnqk,bgnkd->bgrnqd', p[..., :span], vb)
           + jnp.einsum('bgrnqs,bgsd->bgrnqd', p[..., span:span + sc], cv))
    return out.reshape(b, g, r, n, d)


def chunk_gmlp(u, v, w_s, b_s, ln_g, ln_b):
    b, L, _ = v.shape
    vn = layer_norm(v, ln_g, ln_b).reshape(b, L // CHUNK, CHUNK, G_C, C_GROUP)
    s = jnp.einsum('gpq,bnqgc->bnpgc', w_s, vn) + b_s.T[None, None, :, :, None]
    return u * s.reshape(b, L, W_C)


def ffn_sublayer(x, shift, scale, gate, g_pre, g_post, w_gate, w_up, w_down):
    h = rms_norm(x, g_pre) * (1 + scale) + shift
    f = (jax.nn.silu(h @ w_gate) * (h @ w_up)) @ w_down
    return x + gate * rms_norm(f, g_post)


def setup_inputs(seed: int = 0) -> dict:
    key = jax.random.key(seed)
    ks = jax.random.split(key, 26)
    def nrm(k, shape, s):
        return jax.random.normal(k, shape, jnp.float32) * s
    D = D_MODEL
    return {
        'x_prompt': nrm(ks[0], (BATCH, SEQ, D), 1.0),
        'x_sample': nrm(ks[1], (DEC_BATCH, DEC_SEQ, D), 1.0),
        'cache_a_k': nrm(ks[2], (DEC_BATCH, DEPTH, H_A, PAST_LEN, HEAD_DIM), 1.0),
        'cache_a_v': nrm(ks[3], (DEC_BATCH, DEPTH, H_A, PAST_LEN, HEAD_DIM), 1.0),
        'cache_b_k': nrm(ks[4], (DEC_BATCH, DEPTH, KV_B, PAST_LEN, HEAD_DIM), 1.0),
        'cache_b_v': nrm(ks[5], (DEC_BATCH, DEPTH, KV_B, PAST_LEN, HEAD_DIM), 1.0),
        'c': nrm(ks[6], (DEC_BATCH, D), 1.0),
        'c_ctx': nrm(ks[7], (D,), 1.0),
        'mod_w': nrm(ks[8], (DEPTH, D, N_MOD * D), 0.5 * D ** -0.5),
        'mod_b': nrm(ks[9], (DEPTH, N_MOD * D), 0.02),
        'norm_mix_pre': 1.0 + nrm(ks[10], (DEPTH, D), 0.05),
        'norm_mix_post': 1.0 + nrm(ks[11], (DEPTH, D), 0.05),
        'norm_ffn_pre': 1.0 + nrm(ks[12], (DEPTH, D), 0.05),
        'norm_ffn_post': 1.0 + nrm(ks[13], (DEPTH, D), 0.05),
        'w_in': nrm(ks[14], (DEPTH, D, IN_WIDTH), D ** -0.5),
        'w_out': nrm(ks[15], (DEPTH, MIX_WIDTH, D), MIX_WIDTH ** -0.5),
        'rpb_a': nrm(ks[16], (DEPTH, H_A, 2 * NA_ROWS - 1, 2 * NA_COLS - 1), 0.3),
        'sink_b': nrm(ks[17], (DEPTH, KV_B, REP_B), 1.0),
        'gmlp_ln_g': 1.0 + nrm(ks[18], (DEPTH, W_C), 0.05),
        'gmlp_ln_b': nrm(ks[19], (DEPTH, W_C), 0.02),
        'gmlp_w': nrm(ks[20], (DEPTH, G_C, CHUNK, CHUNK), CHUNK ** -0.5),
        'gmlp_b': 1.0 + nrm(ks[21], (DEPTH, G_C, CHUNK), 0.1),
        'w_gate': nrm(ks[22], (DEPTH, D, D_FF), D ** -0.5),
        'w_up': nrm(ks[23], (DEPTH, D, D_FF), D ** -0.5),
        'w_down': nrm(ks[24], (DEPTH, D_FF, D), D_FF ** -0.5),
    }


def reference(x_prompt, x_sample, cache_a_k, cache_a_v, cache_b_k, cache_b_v, c, c_ctx,
              mod_w, mod_b, norm_mix_pre, norm_mix_post, norm_ffn_pre, norm_ffn_post,
              w_in, w_out, rpb_a, sink_b, gmlp_ln_g, gmlp_ln_b, gmlp_w, gmlp_b,
              w_gate, w_up, w_down):
    xp = x_prompt
    ka_list, va_list, kb_list, vb_list = [], [], [], []
    for l in range(DEPTH):
        sm, cm, gm, sf, cf, gf = modulation(c_ctx, mod_w[l], mod_b[l])
        h = rms_norm(xp, norm_mix_pre[l]) * (1 + cm) + sm
        q_a, k_a, v_a, q_b, k_b, v_b, u_c, v_c = split_projection(h, w_in[l])
        o_a = context_attention(q_a[:, :, None], k_a, v_a, None)[:, :, 0]
        o_b = context_attention(q_b, k_b, v_b, sink_b[l])
        o_c = chunk_gmlp(u_c, v_c, gmlp_w[l], gmlp_b[l], gmlp_ln_g[l], gmlp_ln_b[l])
        xp = xp + gm * rms_norm(merge_heads(o_a, o_b, o_c, w_out[l]), norm_mix_post[l])
        xp = ffn_sublayer(xp, sf, cf, gf, norm_ffn_pre[l], norm_ffn_post[l], w_gate[l], w_up[l], w_down[l])
        ka_list.append(k_a)
        va_list.append(v_a)
        kb_list.append(k_b)
        vb_list.append(v_b)
    xs = x_sample
    for l in range(DEPTH):
        sm, cm, gm, sf, cf, gf = modulation(c, mod_w[l], mod_b[l])
        h = rms_norm(xs, norm_mix_pre[l]) * (1 + cm) + sm
        q_a, k_a, v_a, q_b, k_b, v_b, u_c, v_c = split_projection(h, w_in[l])
        o_a = neighbourhood_attention(q_a, k_a, v_a, cache_a_k[:, l], cache_a_v[:, l], rpb_a[l])
        o_b = window_attention(axial_rope(q_b), axial_rope(k_b), v_b,
                               cache_b_k[:, l], cache_b_v[:, l], sink_b[l])
        o_c = chunk_gmlp(u_c, v_c, gmlp_w[l], gmlp_b[l], gmlp_ln_g[l], gmlp_ln_b[l])
        xs = xs + gm * rms_norm(merge_heads(o_a, o_b, o_c, w_out[l]), norm_mix_post[l])
        xs = ffn_sublayer(xs, sf, cf, gf, norm_ffn_pre[l], norm_ffn_post[l], w_gate[l], w_up[l], w_down[l])
    new_a_k = jnp.stack(ka_list, axis=1)
    new_a_v = jnp.stack(va_list, axis=1)
    new_b_k = jnp.stack(kb_list, axis=1)
    new_b_v = jnp.stack(vb_list, axis=1)
    return (xp, xs, new_a_k, new_a_v, new_b_k, new_b_v)
```

```cpp
#include <hip/hip_runtime.h>
#include <cstdio>
#include <cstdint>
#define MK_LAUNCH_MODE 1
constexpr int DM = 2048, DEPTH = 4, NCTX = 8192, MROWS = 16384, INW = 4608, DFF = 5632, NGU = 11264;
constexpr int QA_ = 0, KA_ = 768, VA_ = 1536, QB_ = 2304, KB_ = 3072, VB_ = 3328, UC_ = 3584, VC_ = 4096;
constexpr float ATT_SCALE = 0.08838834764831845f;
constexpr float NORM_EPS = 1e-6f;
constexpr int NWAVES = 8;
enum { I_XP = 0, I_XS, I_CAK, I_CAV, I_CBK, I_CBV, I_C, I_CCTX, I_MODW, I_MODB, I_NMPRE, I_NMPOST, I_NFPRE, I_NFPOST, I_WIN, I_WOUT, I_RPB, I_SINK, I_LNG, I_LNB, I_GW, I_GB, I_WGATE, I_WUP, I_WDOWN, N_IN };
constexpr size_t O_Y = 0, O_AK = 33554432ull, O_AV = 58720256ull, O_BK = 83886080ull, O_BV = 92274688ull, O_END = 100663296ull;
constexpr size_t MiB = 1u << 20;
constexpr size_t WS_CTL = 0, CTL_ZERO_BYTES = 1 * MiB;
constexpr size_t WS_MOD = 1 * MiB;
constexpr size_t WS_ROPE = 3 * MiB;
constexpr size_t WS_CAK = 4 * MiB, WS_CAV = 16 * MiB, WS_CBK = 28 * MiB, WS_CBV = 32 * MiB;
constexpr size_t WS_WIN = 40 * MiB;
constexpr size_t WS_WOUT = 112 * MiB;
constexpr size_t WS_WGU = 144 * MiB;
constexpr size_t WS_WDN = 320 * MiB;
constexpr size_t WS_A = 408 * MiB, WS_B = 472 * MiB;
constexpr size_t WS_H = WS_A;
constexpr size_t WS_Z = WS_B;
constexpr size_t WS_MRG = WS_A;
constexpr size_t WS_F1 = WS_B;
constexpr size_t WS_F2 = WS_A;
constexpr size_t WS_ACT = WS_B;
constexpr size_t WS_XB = 648 * MiB;
constexpr size_t WS_END = 712 * MiB;
constexpr int CW_BAR = 4096;
constexpr int CW_QUEUE = 16384;
constexpr int RING_OFF = 0, RING_BYTES = 131072;
constexpr int LDSCTL_OFF = 143360, MISC_OFF = LDSCTL_OFF + 320;
constexpr int LDS_BYTES = 147456;
static_assert(MISC_OFF + 128 <= LDS_BYTES, "LDS map");

#define GAS __attribute__((address_space(1)))
#define LAS __attribute__((address_space(3)))
typedef unsigned short bf16;
typedef unsigned v4u __attribute__((ext_vector_type(4)));
typedef unsigned v2u __attribute__((ext_vector_type(2)));
typedef float f32x4 __attribute__((ext_vector_type(4)));
typedef short bf16x8 __attribute__((ext_vector_type(8)));
typedef GAS unsigned gu32;
#define RLX_AGENT __ATOMIC_RELAXED, __HIP_MEMORY_SCOPE_AGENT
#define LDS_WAIT() asm volatile("s_waitcnt lgkmcnt(0)" ::: "memory")
#define VM_WAIT() asm volatile("s_waitcnt vmcnt(0)" ::: "memory")
__device__ __forceinline__ unsigned f2bf(float f) { unsigned u = __builtin_bit_cast(unsigned, f); return (u + 0x7fffu + ((u >> 16) & 1u)) >> 16; }
__device__ __forceinline__ unsigned pk2(float lo, float hi) { return f2bf(lo) | (f2bf(hi) << 16); }
__device__ __forceinline__ float bf2f(unsigned short b) { return __uint_as_float(((unsigned)b) << 16); }
__device__ __forceinline__ float bflo(unsigned w) { return __uint_as_float(w << 16); }
__device__ __forceinline__ float bfhi(unsigned w) { return __uint_as_float(w & 0xffff0000u); }
__device__ __forceinline__ float wave_sum(float v) {
#pragma unroll
    for (int o = 1; o < 64; o <<= 1) v += __shfl_xor(v, o);
    return v;
}
__device__ __forceinline__ float wave_max(float v) {
#pragma unroll
    for (int o = 1; o < 64; o <<= 1) v = fmaxf(v, __shfl_xor(v, o));
    return v;
}
__device__ __forceinline__ float fast_sigmoid(float y) { return __builtin_amdgcn_rcpf(1.0f + __builtin_amdgcn_exp2f(-1.4426950408889634f * y)); }
__device__ __forceinline__ float gelu_tanh(float x) { const float y = 0.7978845608028654f * (x + 0.044715f * x * x * x); return x * fast_sigmoid(2.0f * y); }
__device__ __forceinline__ float silu_f(float x) { return x * fast_sigmoid(x); }
#ifndef MK_WGM
#define MK_WGM 8
#endif
namespace pg8 {
#define PG8_LAS __attribute__((address_space(3)))
typedef unsigned short bf16_t;
typedef short bf16x8 __attribute__((ext_vector_type(8)));
typedef float f32x4 __attribute__((ext_vector_type(4)));
typedef unsigned u32x4 __attribute__((ext_vector_type(4)));
constexpr int BM = 256, BK = 64, HALF = 128, HTB = HALF * BK * 2  , STAGE_BYTES = 8 * HTB, NXCD = 8, WGM = MK_WGM;

__host__ __device__ __forceinline__ int lds_byte(int r, int c) { const int st = (r >> 4) * 2 + (c >> 5), rr = r & 15, cc = c & 31, ob = rr * 64 + cc * 2; return st * 1024 + (ob ^ (((ob >> 9) & 1) << 5)); }
__host__ __device__ __forceinline__ void stage_rc(int b, int& R, int& C) { const int st = b / 1024, sb = b % 1024, swz = sb ^ (((sb >> 9) & 1) << 5); R = (st >> 1) * 16 + swz / 64; C = (st & 1) * 32 + (swz % 64) / 2; }
__host__ __device__ __forceinline__ int perm32(int rho) { const int n = rho >> 4, i = rho & 15; return 8 * (i >> 2) + 4 * n + (i & 3); }

struct Unit { int pm, pn; };
struct Gemm { const bf16_t* A; const bf16_t* Bt; int M, N, K; };

struct StaticOrder {
    int nM, nN, nwg, G, c, wgm;
    __host__ __device__ void init(int M, int N, int G_, int c_, int wgm_ = WGM) { nM = M / BM; nN = N / BM; nwg = nM * nN; G = G_; c = c_; wgm = wgm_; }
    __host__ __device__ bool next(int i, Unit& u) const {
        const long L = (long)i * G + c; if (L >= nwg) return false;
        int wgid = (int)L; { const int q = nwg / NXCD, r = nwg % NXCD, xcd = wgid % NXCD, off = wgid / NXCD; wgid = (xcd < r ? xcd * (q + 1) : r * (q + 1) + (xcd - r) * q) + off; }
        const int nig = wgm * nN, gid = wgid / nig, fm = gid * wgm, gsz = (nM - fm) < wgm ? (nM - fm) : wgm;
        u.pm = fm + ((wgid % nig) % gsz); u.pn = (wgid % nig) / gsz; return true;
    }
    __device__ __forceinline__ void a_ready(const Unit&) const {}
    __device__ __forceinline__ void done(const Unit&) const {}
};
__device__ __forceinline__ unsigned cvt_pk_bf16(float lo, float hi) { unsigned r; asm volatile("v_cvt_pk_bf16_f32 %0, %1, %2" : "=v"(r) : "v"(lo), "v"(hi)); return r; }
typedef float f32x2 __attribute__((ext_vector_type(2)));

struct EpiF32 {
    static constexpr bool PERM = false, AFTER_DRAIN = false;
    float* C; int ldc;
    __device__ __forceinline__ void operator()(const f32x4 (&acc)[2][2][4][2], const Unit& u, int wr, int wc, int fr, int fq) const {
        const int row0 = u.pm * BM + wr * 64 + fr, col0 = u.pn * BM + wc * 32 + 4 * fq;
#pragma unroll
        for (int ai = 0; ai < 2; ++ai)
#pragma unroll
            for (int m = 0; m < 4; ++m) { float* rowp = C + (size_t)(row0 + ai * HALF + m * 16) * ldc + col0;
#pragma unroll
                for (int bj = 0; bj < 2; ++bj)
#pragma unroll
                    for (int n = 0; n < 2; ++n) *(f32x4*)(rowp + bj * HALF + n * 16) = acc[ai][bj][m][n]; }
    }
};
struct EpiWin {
    static constexpr bool PERM = true, AFTER_DRAIN = false;
    bf16_t* Z; float* out; int layer;
    __device__ __forceinline__ void operator()(const f32x4 (&acc)[2][2][4][2], const Unit& u, int wr, int wc, int fr, int fq) const {
        const int row0 = u.pm * BM + wr * 64 + fr, colb = u.pn * BM + wc * 32 + 8 * fq;
        const bool act = u.pn >= 14;
        bool kv = false; size_t kvbase = 0; int nh = 6, h0 = 0;
        if (u.pm < 32) {
            if (u.pn >= 3 && u.pn <= 5)      { kv = true; kvbase = 33554432ull; nh = 6; h0 = 2 * (u.pn - 3); }
            else if (u.pn >= 6 && u.pn <= 8) { kv = true; kvbase = 58720256ull; nh = 6; h0 = 2 * (u.pn - 6); }
            else if (u.pn == 12)             { kv = true; kvbase = 83886080ull; nh = 2; h0 = 0; }
            else if (u.pn == 13)             { kv = true; kvbase = 92274688ull; nh = 2; h0 = 0; }
        }
#pragma unroll
        for (int ai = 0; ai < 2; ++ai)
#pragma unroll
            for (int m = 0; m < 4; ++m) { const int row = row0 + ai * HALF + m * 16; bf16_t* rowp = Z + (size_t)row * 4608 + colb;
#pragma unroll
                for (int bj = 0; bj < 2; ++bj) { f32x4 v0 = acc[ai][bj][m][0], v1 = acc[ai][bj][m][1];
                    if (kv) { float* p = out + kvbase + ((((size_t)u.pm * 4 + layer) * nh + h0 + bj) * 256 + (row - u.pm * BM)) * 128 + wc * 32 + 8 * fq;
                        __builtin_nontemporal_store(v0, (f32x4*)p); __builtin_nontemporal_store(v1, (f32x4*)(p + 4)); }
                    if (act) {
#pragma unroll
                        for (int j = 0; j < 4; ++j) { v0[j] = gelu_tanh(v0[j]); v1[j] = gelu_tanh(v1[j]); } }
                    u32x4 w; w.x = cvt_pk_bf16(v0[0], v0[1]); w.y = cvt_pk_bf16(v0[2], v0[3]); w.z = cvt_pk_bf16(v1[0], v1[1]); w.w = cvt_pk_bf16(v1[2], v1[3]);
                    *(u32x4*)(rowp + bj * HALF) = w; } }
    }
};
struct EpiGU {
    static constexpr bool PERM = true, AFTER_DRAIN = false;
    bf16_t* O;
    __device__ __forceinline__ void operator()(const f32x4 (&acc)[2][2][4][2], const Unit& u, int wr, int wc, int fr, int fq) const {
        const int row0 = u.pm * BM + wr * 64 + fr, col0 = u.pn * HALF + wc * 32 + 8 * fq;
#pragma unroll
        for (int ai = 0; ai < 2; ++ai)
#pragma unroll
            for (int m = 0; m < 4; ++m) { bf16_t* rowp = O + (size_t)(row0 + ai * HALF + m * 16) * 5632 + col0;
                f32x4 v0, v1;
#pragma unroll
                for (int j = 0; j < 4; ++j) { v0[j] = silu_f(acc[ai][0][m][0][j]) * acc[ai][1][m][0][j]; v1[j] = silu_f(acc[ai][0][m][1][j]) * acc[ai][1][m][1][j]; }
                u32x4 w; w.x = cvt_pk_bf16(v0[0], v0[1]); w.y = cvt_pk_bf16(v0[2], v0[3]); w.z = cvt_pk_bf16(v1[0], v1[1]); w.w = cvt_pk_bf16(v1[2], v1[3]);
                *(u32x4*)rowp = w; }
    }
};

struct EpiBf16 {
    static constexpr bool PERM = true, AFTER_DRAIN = false;
    bf16_t* O; int ldc;
    __device__ __forceinline__ void operator()(const f32x4 (&acc)[2][2][4][2], const Unit& u, int wr, int wc, int fr, int fq) const {
        const int row0 = u.pm * BM + wr * 64 + fr, col0 = u.pn * BM + wc * 32 + 8 * fq;
#pragma unroll
        for (int ai = 0; ai < 2; ++ai)
#pragma unroll
            for (int m = 0; m < 4; ++m) { bf16_t* rowp = O + (size_t)(row0 + ai * HALF + m * 16) * ldc + col0;
#pragma unroll
                for (int bj = 0; bj < 2; ++bj) { const f32x4 v0 = acc[ai][bj][m][0], v1 = acc[ai][bj][m][1];
                    u32x4 w; w.x = cvt_pk_bf16(v0[0], v0[1]); w.y = cvt_pk_bf16(v0[2], v0[3]); w.z = cvt_pk_bf16(v1[0], v1[1]); w.w = cvt_pk_bf16(v1[2], v1[3]);
                    *(u32x4*)(rowp + bj * HALF) = w; } }
    }
};
template <class Epi, class Sched, bool ALIGN_EPI = false, bool SP2 = false>
__device__ __forceinline__ void gemm_phase(PG8_LAS unsigned char* lds, const Gemm g, const Sched& S, const Epi& E, const int wave_id  ) {
    int tid_l = (int)__builtin_amdgcn_mbcnt_hi(~0u, __builtin_amdgcn_mbcnt_lo(~0u, 0u)); asm volatile("" : "+v"(tid_l)); tid_l += 64 * wave_id;
    const int tid = tid_l, wid = __builtin_amdgcn_readfirstlane(tid >> 6), lane = tid & 63, wr = wid >> 2, wc = wid & 3, fr = lane & 15, fq = lane >> 4;
    const int K = g.K, nt = K / BK;
    unsigned voffA[2], voffB[2];
#pragma unroll
    for (int i = 0; i < 2; ++i) { int R, C; stage_rc(tid * 16 + i * 8192, R, C); const int Rb = Epi::PERM ? ((R & ~31) + perm32(R & 31)) : R;
        voffA[i] = (unsigned)(R * K + C) * 2u; voffB[i] = (unsigned)(Rb * K + C) * 2u; }
    const size_t kstep = (size_t)(BK * 2);
    const size_t hstep = (size_t)HALF * K * 2;
    const size_t tstep = 2 * hstep;
    const unsigned ldsw = (unsigned)wid * 1024u;
    const int aoff = lds_byte(wr * 64 + fr, fq * 8), boff = lds_byte(wc * 32 + fr, fq * 8);
#define PG8_SA(b, h) (((b) * 2 + (h)) * HTB)
#define PG8_SB(b, h) ((4 + (b) * 2 + (h)) * HTB)
#define PG8_STAGE(bufoff, gbase, voff) do { _Pragma("unroll") for (int _i = 0; _i < 2; ++_i) \
        __builtin_amdgcn_global_load_lds((const unsigned*)((const char*)(gbase) + (voff)[_i]), (PG8_LAS unsigned*)(lds + (bufoff) + ldsw + _i * 8192), 16, 0, 0); } while (0)
#define PG8_LDA(dst, b, h) do { _Pragma("unroll") for (int m = 0; m < 4; ++m) _Pragma("unroll") for (int k = 0; k < 2; ++k) dst[m][k] = *(const PG8_LAS bf16x8*)(lds + PG8_SA(b, h) + aoff + m * 2048 + k * 1024); } while (0)
#define PG8_LDB(dst, b, h) do { _Pragma("unroll") for (int n = 0; n < 2; ++n) _Pragma("unroll") for (int k = 0; k < 2; ++k) dst[n][k] = *(const PG8_LAS bf16x8*)(lds + PG8_SB(b, h) + boff + n * 2048 + k * 1024); } while (0)
#define PG8_MMA(ai, bj, At, Bt) do { __builtin_amdgcn_s_setprio(1); _Pragma("unroll") for (int m = 0; m < 4; ++m) _Pragma("unroll") for (int n = 0; n < 2; ++n) _Pragma("unroll") for (int k = 0; k < 2; ++k) \
        acc[ai][bj][m][n] = __builtin_amdgcn_mfma_f32_16x16x32_bf16(Bt[n][k], At[m][k], acc[ai][bj][m][n], 0, 0, 0); __builtin_amdgcn_s_setprio(0); } while (0)
#define PG8_WAIT_V(n) asm volatile("s_waitcnt vmcnt(" #n ")" ::: "memory")
#define PG8_WAIT_L(n) asm volatile("s_waitcnt lgkmcnt(" #n ")" ::: "memory")
#define PG8_BAR __builtin_amdgcn_s_barrier()
#define PG8_SCHED __builtin_amdgcn_sched_barrier(0)
    Unit cur, nxt; int ui = 0;
    if (!S.next(0, cur)) return;
    f32x4 acc[2][2][4][2];
#pragma unroll
    for (int a = 0; a < 2; ++a)
#pragma unroll
        for (int b = 0; b < 2; ++b)
#pragma unroll
            for (int m = 0; m < 4; ++m)
#pragma unroll
                for (int n = 0; n < 2; ++n) acc[a][b][m][n] = (f32x4){0.f, 0.f, 0.f, 0.f};
    bf16x8 At[4][2], B0[2][2], B1[2][2];
    const char* cA = (const char*)g.A + (size_t)cur.pm * tstep; const char* cB = (const char*)g.Bt + (size_t)cur.pn * tstep;
    S.a_ready(cur);
    if constexpr (SP2) {
        PG8_STAGE(PG8_SB(0, 0), cB, voffB); PG8_STAGE(PG8_SB(0, 1), cB + hstep, voffB); PG8_STAGE(PG8_SA(0, 0), cA, voffA); PG8_STAGE(PG8_SA(0, 1), cA + hstep, voffA);
        if (wr == 1) PG8_BAR;
        PG8_WAIT_V(2); PG8_BAR;
        PG8_STAGE(PG8_SB(1, 0), cB + kstep, voffB); PG8_STAGE(PG8_SA(1, 0), cA + kstep, voffA); PG8_STAGE(PG8_SB(1, 1), cB + hstep + kstep, voffB);
        PG8_WAIT_V(6); PG8_BAR;
    } else {
        PG8_STAGE(PG8_SB(0, 0), cB, voffB); PG8_STAGE(PG8_SA(0, 0), cA, voffA); PG8_STAGE(PG8_SB(0, 1), cB + hstep, voffB); PG8_STAGE(PG8_SA(0, 1), cA + hstep, voffA);
        if (wr == 1) PG8_BAR;
        PG8_WAIT_V(4); PG8_BAR;
        PG8_STAGE(PG8_SB(1, 0), cB + kstep, voffB); PG8_STAGE(PG8_SA(1, 0), cA + kstep, voffA); PG8_STAGE(PG8_SB(1, 1), cB + hstep + kstep, voffB);
        PG8_WAIT_V(6); PG8_BAR;
    }
    for (;;) {
        const bool has_next = S.next(ui + 1, nxt);
        const char* nA = has_next ? (const char*)g.A + (size_t)nxt.pm * tstep : cA; const char* nB = has_next ? (const char*)g.Bt + (size_t)nxt.pn * tstep : cB;
        for (int t = 0; t < nt; t += 2) {
            const bool last = (t == nt - 2);
            const char* a1 = cA + (size_t)(t + 1) * kstep;
            const char* a2 = last ? nA : cA + (size_t)(t + 2) * kstep; const char* b2 = last ? nB : cB + (size_t)(t + 2) * kstep;
            const char* a3 = a2 + kstep; const char* b3 = b2 + kstep;
            if (last && has_next) S.a_ready(nxt);
            if constexpr (SP2) {
            PG8_LDB(B0, 0, 0); PG8_LDB(B1, 0, 1); PG8_SCHED; PG8_LDA(At, 0, 0); PG8_STAGE(PG8_SA(1, 1), a1 + hstep, voffA);
            PG8_WAIT_V(8); PG8_WAIT_L(0); PG8_BAR; PG8_MMA(0, 0, At, B0); PG8_MMA(0, 1, At, B1); PG8_BAR; PG8_SCHED;
            PG8_LDA(At, 0, 1); PG8_STAGE(PG8_SB(0, 0), b2, voffB); PG8_STAGE(PG8_SB(0, 1), b2 + hstep, voffB); PG8_STAGE(PG8_SA(0, 0), a2, voffA);
            PG8_WAIT_V(8); PG8_WAIT_L(0); PG8_BAR; PG8_MMA(1, 0, At, B0); PG8_MMA(1, 1, At, B1); PG8_BAR; PG8_SCHED;
            PG8_LDB(B0, 1, 0); PG8_LDB(B1, 1, 1); PG8_SCHED; PG8_LDA(At, 1, 0); PG8_STAGE(PG8_SA(0, 1), a2 + hstep, voffA);
            PG8_WAIT_V(8); PG8_WAIT_L(0); PG8_BAR; PG8_MMA(0, 0, At, B0); PG8_MMA(0, 1, At, B1); PG8_BAR; PG8_SCHED;
            PG8_LDA(At, 1, 1); PG8_STAGE(PG8_SB(1, 0), b3, voffB); PG8_STAGE(PG8_SB(1, 1), b3 + hstep, voffB); PG8_STAGE(PG8_SA(1, 0), a3, voffA);
            PG8_WAIT_V(8); PG8_WAIT_L(0); PG8_BAR; PG8_MMA(1, 0, At, B0); PG8_MMA(1, 1, At, B1); PG8_BAR; PG8_SCHED;
            } else {
            PG8_LDB(B0, 0, 0); PG8_SCHED; PG8_LDA(At, 0, 0); PG8_STAGE(PG8_SA(1, 1), a1 + hstep, voffA);
            PG8_WAIT_L(8); PG8_BAR; PG8_WAIT_L(0); PG8_MMA(0, 0, At, B0); PG8_BAR; PG8_SCHED;
            PG8_LDB(B1, 0, 1); PG8_STAGE(PG8_SB(0, 0), b2, voffB);
            PG8_BAR; PG8_WAIT_L(0); PG8_MMA(0, 1, At, B1); PG8_BAR;
            PG8_LDA(At, 0, 1); PG8_STAGE(PG8_SA(0, 0), a2, voffA);
            PG8_BAR; PG8_WAIT_L(0); PG8_MMA(1, 0, At, B0); PG8_BAR; PG8_SCHED;
            PG8_STAGE(PG8_SB(0, 1), b2 + hstep, voffB);
            PG8_WAIT_V(6); PG8_BAR; PG8_MMA(1, 1, At, B1); PG8_BAR;
            PG8_LDB(B0, 1, 0); PG8_SCHED; PG8_LDA(At, 1, 0); PG8_STAGE(PG8_SA(0, 1), a2 + hstep, voffA);
            PG8_WAIT_L(8); PG8_BAR; PG8_WAIT_L(0); PG8_MMA(0, 0, At, B0); PG8_BAR; PG8_SCHED;
            PG8_LDB(B1, 1, 1); PG8_STAGE(PG8_SB(1, 0), b3, voffB);
            PG8_BAR; PG8_WAIT_L(0); PG8_MMA(0, 1, At, B1); PG8_BAR;
            PG8_LDA(At, 1, 1); PG8_STAGE(PG8_SA(1, 0), a3, voffA);
            PG8_BAR; PG8_WAIT_L(0); PG8_MMA(1, 0, At, B0); PG8_BAR; PG8_SCHED;
            PG8_STAGE(PG8_SB(1, 1), b3 + hstep, voffB);
            PG8_WAIT_V(6); PG8_BAR; PG8_MMA(1, 1, At, B1); PG8_BAR;
            }
        }
        if constexpr (ALIGN_EPI) { if (wr == 0) PG8_BAR; }
        if constexpr (!Epi::AFTER_DRAIN) { E(acc, cur, wr, wc, fr, fq); S.done(cur); }
        if (!has_next) break;
#pragma unroll
        for (int a = 0; a < 2; ++a)
#pragma unroll
            for (int b = 0; b < 2; ++b)
#pragma unroll
                for (int m = 0; m < 4; ++m)
#pragma unroll
                    for (int n = 0; n < 2; ++n) acc[a][b][m][n] = (f32x4){0.f, 0.f, 0.f, 0.f};
        cur = nxt; cA = nA; cB = nB; ++ui;
        if constexpr (ALIGN_EPI) { if (wr == 1) PG8_BAR; }
    }
    PG8_WAIT_V(0);
    if constexpr (!ALIGN_EPI) { if (wr == 0) PG8_BAR; }
    PG8_BAR;
    if constexpr (Epi::AFTER_DRAIN) { E.fused(acc, cur, wr, wc, fr, fq, lds, wid, lane); S.done(cur); }
#undef PG8_SA
#undef PG8_SB
#undef PG8_STAGE
#undef PG8_LDA
#undef PG8_LDB
#undef PG8_MMA
#undef PG8_WAIT_V
#undef PG8_WAIT_L
#undef PG8_BAR
#undef PG8_SCHED
}
}
#define XB_TMO      128
#define XB_XCNT(j)  (256  + 64 * (j))
#define XB_XSUB(j)  (1280 + 64 * (j))
#define XB_XGEN(j)  (2304 + 64 * (j))
#define XB_TOP      3328
#define XB_TOPGEN   3392
#define XCD_BAR_WORDS 3456
#define XB_SPIN_CAP (1u << 18)

__device__ __forceinline__ unsigned xb_ld(unsigned* p)              { return __hip_atomic_load(p, __ATOMIC_RELAXED, __HIP_MEMORY_SCOPE_AGENT); }
__device__ __forceinline__ unsigned xb_add(unsigned* p, unsigned v) { return __hip_atomic_fetch_add(p, v, __ATOMIC_RELAXED, __HIP_MEMORY_SCOPE_AGENT); }
__device__ __forceinline__ unsigned xb_xcc_id() { return (unsigned)__builtin_amdgcn_s_getreg((3 << 11) | 20) & 0xFu; }
#define XB_SPIN(cond, bar) do { unsigned _sp = 0; while (cond) { __builtin_amdgcn_s_sleep(1); \
    if ((++_sp & 255u) == 0u) { if (xb_ld(&(bar)[XB_TMO])) break; if (_sp > XB_SPIN_CAP) { atomicAdd(&(bar)[XB_TMO], 1u); break; } } } } while (0)

struct XcdBarrier {
    unsigned* bar; unsigned x;
    volatile LAS unsigned* st;
};

__device__ __forceinline__ XcdBarrier xcd_barrier_post(unsigned* bar, volatile LAS unsigned* st) {
    XcdBarrier b; b.bar = bar; b.x = xb_xcc_id(); b.st = st;
    if (threadIdx.x == 0) (void)xb_add(&bar[XB_XCNT(b.x)], 1u);
    return b;
}
__device__ __forceinline__ void xcd_barrier_complete(unsigned* bar, unsigned x, unsigned& nloc, unsigned& nx) {
    const unsigned G = gridDim.x * gridDim.y * gridDim.z;
    unsigned sum, cnt, mine, sp = 0u;
    for (;;) {
        sum = 0u; cnt = 0u; mine = 0u;
#pragma unroll
        for (unsigned j = 0; j < 16; ++j) { const unsigned c = xb_ld(&bar[XB_XCNT(j)]); sum += c; cnt += (c > 0u) ? 1u : 0u; mine = (j == x) ? c : mine; }
        if (sum == G) break;
        __builtin_amdgcn_s_sleep(1);
        if ((++sp & 255u) == 0u) { if (xb_ld(&bar[XB_TMO])) break; if (sp > XB_SPIN_CAP) { atomicAdd(&bar[XB_TMO], 1u); break; } }
    }
    nloc = mine > 0u ? mine : 1u; nx = cnt > 0u ? cnt : 1u;
}

__device__ __forceinline__ void xcd_barrier(const XcdBarrier& b) {
    asm volatile("s_waitcnt vmcnt(0)" ::: "memory");
    __syncthreads();
    if (threadIdx.x == 0) {
        unsigned* bar = b.bar;
        __builtin_amdgcn_s_waitcnt(0);
        unsigned nloc = b.st[0], nx = b.st[1];
        if (nloc == 0u) { xcd_barrier_complete(bar, b.x, nloc, nx); b.st[0] = nloc; b.st[1] = nx; }
        const unsigned old = xb_add(&bar[XB_XSUB(b.x)], 1u);
        const unsigned gen = old / nloc;
        if (old + 1u == (gen + 1u) * nloc) {
            __builtin_amdgcn_fence(__ATOMIC_RELEASE, "agent");
            asm volatile("s_waitcnt vmcnt(0)" ::: "memory");
            const unsigned og = xb_add(&bar[XB_TOP], 1u);
            const unsigned tg = og / nx;
            if (og + 1u == (tg + 1u) * nx) xb_add(&bar[XB_TOPGEN], 1u);
            else XB_SPIN(xb_ld(&bar[XB_TOPGEN]) == tg, bar);
            __builtin_amdgcn_fence(__ATOMIC_ACQUIRE, "agent");
            xb_add(&bar[XB_XGEN(b.x)], 1u);
            asm volatile("s_waitcnt vmcnt(0)" ::: "memory");
        } else {
            XB_SPIN(xb_ld(&bar[XB_XGEN(b.x)]) == gen, bar);
            __builtin_amdgcn_fence(__ATOMIC_ACQUIRE, "agent");
            asm volatile("s_waitcnt vmcnt(0)" ::: "memory");
        }
    }
    __syncthreads();
}
struct Args { const float* in[N_IN]; float* out; unsigned char* ws; int ph_lo, ph_hi; };

#ifndef MK_CONV_TAIL
#define MK_CONV_TAIL 16
#endif
__device__ __forceinline__ void p0_transpose_item(const float* W, int K, int N, bf16* WT, int dmode, LAS float* scr, int item, int lane) {
    const int nblk = N / 32, kb = item / nblk, nb = item % nblk, k0 = 64 * kb, n0 = 32 * nb;
#pragma unroll 8
    for (int i = 0; i < 32; ++i) { const int kk = 2 * i + (lane >> 5); scr[kk * 33 + (lane & 31)] = W[(size_t)(k0 + kk) * N + n0 + (lane & 31)]; }
    LDS_WAIT(); asm volatile("" ::: "memory");
    const int c = lane & 7;
    const int d0 = dmode == 0 ? n0 : ((n0 >> 7) * 256 + (n0 & 127) + (dmode == 2 ? 128 : 0));
#pragma unroll
    for (int j = 0; j < 4; ++j) { const int n = (lane >> 3) + 8 * j; const LAS float* s = scr + (8 * c) * 33 + n;
        v4u o; o.x = pk2(s[0 * 33], s[1 * 33]); o.y = pk2(s[2 * 33], s[3 * 33]); o.z = pk2(s[4 * 33], s[5 * 33]); o.w = pk2(s[6 * 33], s[7 * 33]);
        *(GAS v4u*)(WT + (size_t)(d0 + n) * K + k0 + 8 * c) = o; }
    LDS_WAIT(); asm volatile("" ::: "memory");
}
#ifndef MODR
#define MODR 8
#endif
__device__ __forceinline__ void p0_mod_unit(const Args& a, int unit, LAS unsigned char* lds, int tid, int wave, int lane) {
    const int l = unit / 48, jb = unit % 48;
    LAS float* S = (LAS float*)lds;
    for (int i = tid; i < 9 * DM; i += NWAVES * 64) { const int mi = i / DM, k = i % DM; const float x = mi == 0 ? a.in[I_CCTX][k] : a.in[I_C][(mi - 1) * DM + k]; S[i] = silu_f(x); }
    __syncthreads();
    const float* W = a.in[I_MODW] + (size_t)l * DM * 12288 + jb * 256 + 4 * lane;
    f32x4 acc[9];
#pragma unroll
    for (int mi = 0; mi < 9; ++mi) acc[mi] = (f32x4){0.f, 0.f, 0.f, 0.f};
    const int kbeg = wave * 256;
    f32x4 wa[MODR], wb[MODR];
#define MOD_FMA(WS, KB) do { _Pragma("unroll") for (int i_ = 0; i_ < MODR; ++i_) { _Pragma("unroll") for (int mi = 0; mi < 9; ++mi) { const float s = S[mi * DM + (KB) + i_]; acc[mi] += WS[i_] * s; } } } while (0)
#pragma unroll
    for (int i = 0; i < MODR; ++i) wa[i] = __builtin_nontemporal_load((const f32x4*)(W + (size_t)(kbeg + i) * 12288));
#pragma unroll 1
    for (int kk = 0; kk < 256; kk += 2 * MODR) {
#pragma unroll
        for (int i = 0; i < MODR; ++i) wb[i] = __builtin_nontemporal_load((const f32x4*)(W + (size_t)(kbeg + kk + MODR + i) * 12288));
        MOD_FMA(wa, kbeg + kk);
        if (kk + 2 * MODR < 256) {
#pragma unroll
            for (int i = 0; i < MODR; ++i) wa[i] = __builtin_nontemporal_load((const f32x4*)(W + (size_t)(kbeg + kk + 2 * MODR + i) * 12288)); }
        MOD_FMA(wb, kbeg + kk + MODR);
    }
#undef MOD_FMA
    __syncthreads();
    LAS float* R = (LAS float*)lds;
#pragma unroll
    for (int mi = 0; mi < 9; ++mi) *(LAS f32x4*)(R + (wave * 9 + mi) * 256 + 4 * lane) = acc[mi];
    __syncthreads();
    float* MOD = (float*)(a.ws + WS_MOD);
    for (int i = tid; i < 9 * 256; i += NWAVES * 64) { const int mi = i >> 8, c = i & 255; float s = 0.f;
#pragma unroll
        for (int w = 0; w < 8; ++w) s += R[(w * 9 + mi) * 256 + c];
        const int j = jb * 256 + c; MOD[((size_t)l * 9 + mi) * 12288 + j] = s + a.in[I_MODB][l * 12288 + j]; }
    __syncthreads();
}
struct ConvItem { const float* src; bf16* dst; int N, K; };
__device__ __forceinline__ ConvItem p0_conv_decode(const Args& a, int l, int it) {
    constexpr int I_IN = (DM / 64) * (INW / 32), I_OUT = (DM / 64) * (DM / 32), I_G = (DM / 64) * (DFF / 32);
    const float* W; bf16* WT; int K, N, dmode, r = it;
    if (r < I_IN) { W = a.in[I_WIN] + (size_t)l * DM * INW; K = DM; N = INW; WT = (bf16*)(a.ws + WS_WIN) + (size_t)l * INW * DM; dmode = 0; }
    else if ((r -= I_IN) < I_OUT) { W = a.in[I_WOUT] + (size_t)l * DM * DM; K = DM; N = DM; WT = (bf16*)(a.ws + WS_WOUT) + (size_t)l * DM * DM; dmode = 0; }
    else if ((r -= I_OUT) < I_G) { W = a.in[I_WGATE] + (size_t)l * DM * DFF; K = DM; N = DFF; WT = (bf16*)(a.ws + WS_WGU) + (size_t)l * NGU * DM; dmode = 1; }
    else if ((r -= I_G) < I_G) { W = a.in[I_WUP] + (size_t)l * DM * DFF; K = DM; N = DFF; WT = (bf16*)(a.ws + WS_WGU) + (size_t)l * NGU * DM; dmode = 2; }
    else { r -= I_G; W = a.in[I_WDOWN] + (size_t)l * DFF * DM; K = DFF; N = DM; WT = (bf16*)(a.ws + WS_WDN) + (size_t)l * DM * DFF; dmode = 0; }
    const int nblk = N / 32, kb = r / nblk, nb = r % nblk, k0 = 64 * kb, n0 = 32 * nb;
    const int d0 = dmode == 0 ? n0 : ((n0 >> 7) * 256 + (n0 & 127) + (dmode == 2 ? 128 : 0));
    ConvItem c; c.src = W + (size_t)k0 * N + n0; c.dst = WT + (size_t)d0 * K + k0; c.N = N; c.K = K; return c;
}
__device__ __forceinline__ void p0_convert_layer(const Args& a, int l, LAS unsigned char* lds, int wave, int lane, int gw0, int ngw, int sixteenths_lo, int sixteenths_hi) {
    LAS float* scr = (LAS float*)(lds + RING_OFF + wave * 16384);
    constexpr int PER_L = (DM / 64) * (INW / 32) + (DM / 64) * (DM / 32) + 2 * (DM / 64) * (DFF / 32) + (DFF / 64) * (DM / 32);
    const int it_lo = PER_L / 16 * sixteenths_lo, it_hi = sixteenths_hi >= 16 ? PER_L : PER_L / 16 * sixteenths_hi, gw = it_lo + gw0;
    if (gw >= it_hi) return;
    float ld[32];
    ConvItem cur = p0_conv_decode(a, l, gw);
    { const float* s = cur.src + (size_t)(lane >> 5) * cur.N + (lane & 31);
#pragma unroll
      for (int i = 0; i < 32; ++i) ld[i] = __builtin_nontemporal_load(s + (size_t)(2 * i) * cur.N);     }
    for (int it = gw;; it += ngw) {
#pragma unroll
        for (int i = 0; i < 32; ++i) scr[(2 * i + (lane >> 5)) * 33 + (lane & 31)] = ld[i];
        LDS_WAIT(); asm volatile("" ::: "memory");
        const bool more = it + ngw < it_hi; ConvItem nxt = cur;
        if (more) { nxt = p0_conv_decode(a, l, it + ngw); const float* s = nxt.src + (size_t)(lane >> 5) * nxt.N + (lane & 31);
#pragma unroll
            for (int i = 0; i < 32; ++i) ld[i] = __builtin_nontemporal_load(s + (size_t)(2 * i) * nxt.N); }
        const int c = lane & 7;
#pragma unroll
        for (int j = 0; j < 4; ++j) { const int n = (lane >> 3) + 8 * j; const LAS float* s = scr + (8 * c) * 33 + n;
            v4u o; o.x = pk2(s[0 * 33], s[1 * 33]); o.y = pk2(s[2 * 33], s[3 * 33]); o.z = pk2(s[4 * 33], s[5 * 33]); o.w = pk2(s[6 * 33], s[7 * 33]);
            __builtin_nontemporal_store(o, (GAS v4u*)(cur.dst + (size_t)n * cur.K + 8 * c)); }
        LDS_WAIT(); asm volatile("" ::: "memory");
        if (!more) break;
        cur = nxt;
    }
}
__device__ __forceinline__ void p0_prologue(const Args& a, LAS unsigned char* lds, int tid, int wave, int lane, int G) {
    const int bid = blockIdx.x;
    for (int u = bid; u < 192; u += G) p0_mod_unit(a, u, lds, tid, wave, lane);
    { const int gt = bid * (NWAVES * 64) + tid; if (gt < 2048) { const int pos = gt >> 5, i = gt & 31; const float fr = exp2f(-(float)i * (13.287712379549449f / 32.0f)); const float ang = (float)pos * fr;
        float* R = (float*)(a.ws + WS_ROPE); R[gt * 2] = cosf(ang); R[gt * 2 + 1] = sinf(ang); } }
    { const size_t gt = (size_t)bid * (NWAVES * 64) + tid, nthr = (size_t)G * NWAVES * 64;
      const size_t n8a = 6291456 / 8, n8b = 2097152 / 8;
      for (size_t i = gt; i < 2 * n8a + 2 * n8b; i += nthr) {
          const float* src; bf16* dst; size_t j = i;
          if (j < n8a) { src = a.in[I_CAK]; dst = (bf16*)(a.ws + WS_CAK); }
          else if ((j -= n8a) < n8a) { src = a.in[I_CAV]; dst = (bf16*)(a.ws + WS_CAV); }
          else if ((j -= n8a) < n8b) { src = a.in[I_CBK]; dst = (bf16*)(a.ws + WS_CBK); }
          else { j -= n8b; src = a.in[I_CBV]; dst = (bf16*)(a.ws + WS_CBV); }
          const f32x4 x0 = __builtin_nontemporal_load((const f32x4*)(src + j * 8)), x1 = __builtin_nontemporal_load((const f32x4*)(src + j * 8 + 4));
          v4u o; o.x = pk2(x0[0], x0[1]); o.y = pk2(x0[2], x0[3]); o.z = pk2(x1[0], x1[1]); o.w = pk2(x1[2], x1[3]);
          *(v4u*)(dst + j * 8) = o; } }
    for (int l = 0; l < DEPTH; ++l) p0_convert_layer(a, l, lds, wave, lane, wave * G + bid, G * NWAVES, l == 0 ? 0 : MK_CONV_TAIL, 16);
}

#ifndef MK_XBF16
#define MK_XBF16 1
#endif
struct ThinRow { v4u f[4]; f32x4 x[8]; v4u xb[4]; };
template <int MODE>
__device__ __forceinline__ void thin_load(ThinRow& r, const Args& a, int row, int lane, size_t f_off) {
    if (MODE == 0 || !MK_XBF16) {
        const float* xs = MODE == 0 ? (row < NCTX ? a.in[I_XP] + (size_t)row * DM : a.in[I_XS] + (size_t)(row - NCTX) * DM) : a.out + (size_t)row * DM;
#pragma unroll
        for (int j = 0; j < 4; ++j) { if (MODE == 0) { r.x[2 * j] = __builtin_nontemporal_load((const f32x4*)(xs + 8 * lane + 512 * j)); r.x[2 * j + 1] = __builtin_nontemporal_load((const f32x4*)(xs + 8 * lane + 512 * j + 4)); }
            else { r.x[2 * j] = *(const f32x4*)(xs + 8 * lane + 512 * j); r.x[2 * j + 1] = *(const f32x4*)(xs + 8 * lane + 512 * j + 4); } }
    } else { const bf16* xs = (const bf16*)(a.ws + WS_XB) + (size_t)row * DM;
#pragma unroll
        for (int j = 0; j < 4; ++j) r.xb[j] = *(const v4u*)(xs + 8 * lane + 512 * j); }
    if (MODE == 1) { const bf16* fs = (const bf16*)(a.ws + f_off) + (size_t)row * DM;
#pragma unroll
        for (int j = 0; j < 4; ++j) r.f[j] = __builtin_nontemporal_load((const v4u*)(fs + 8 * lane + 512 * j)); }
}
__device__ __forceinline__ void unpack8f(const v4u w, f32x4& a, f32x4& b) { a = (f32x4){bflo(w.x), bfhi(w.x), bflo(w.y), bfhi(w.y)}; b = (f32x4){bflo(w.z), bfhi(w.z), bflo(w.w), bfhi(w.w)}; }
template <int MODE, bool HAS_H>
__device__ __forceinline__ void thin_phase(const Args& a, LAS unsigned char* lds, int tid, int wave, int lane, int G, const float* gpost, int gate_sel, int lgate, const float* gpre, int scale_sel, int shift_sel, int lnext) {
    const size_t f_off = gate_sel == 5 ? WS_F2 : WS_F1;
    float* X = a.out; bf16* XB = (bf16*)(a.ws + WS_XB); bf16* H = (bf16*)(a.ws + WS_H); const float* MOD = (const float*)(a.ws + WS_MOD);
    constexpr bool XOUT_BF = MK_XBF16 && HAS_H;
    LAS float* VG = (LAS float*)lds; LAS float* VW = VG + DM; LAS float* VS = VW + DM;
    for (int chunk = blockIdx.x; chunk < MROWS / 64; chunk += G) {
        const int r0 = chunk * 64, mi = r0 < NCTX ? 0 : 1 + ((r0 - NCTX) >> 10);
        { const int c = 4 * tid;
          if (MODE == 1) { const f32x4 gt = *(const f32x4*)(MOD + ((size_t)lgate * 9 + mi) * 12288 + gate_sel * DM + c), gp = *(const f32x4*)(gpost + c); *(LAS f32x4*)(VG + c) = gt * gp; }
          if (HAS_H) { const f32x4 gp = *(const f32x4*)(gpre + c), s1 = *(const f32x4*)(MOD + ((size_t)lnext * 9 + mi) * 12288 + scale_sel * DM + c), s0 = *(const f32x4*)(MOD + ((size_t)lnext * 9 + mi) * 12288 + shift_sel * DM + c);
              *(LAS f32x4*)(VW + c) = gp * (s1 + 1.0f); *(LAS f32x4*)(VS + c) = s0; } }
        ThinRow cur, nxt;
        const int rw = r0 + wave * 8;
        thin_load<MODE>(cur, a, rw, lane, f_off);
        __syncthreads();
        for (int k = 0; k < 8; ++k) {
            const int row = rw + k;
            if (k + 1 < 8) thin_load<MODE>(nxt, a, row + 1, lane, f_off);
            f32x4 x[8];
            if (MODE == 0) {
#pragma unroll
                for (int j = 0; j < 8; ++j) x[j] = cur.x[j];
            } else {
                f32x4 f[8], xo[8]; float ss = 0.f;
#pragma unroll
                for (int j = 0; j < 4; ++j) { unpack8f(cur.f[j], f[2 * j], f[2 * j + 1]); if (MK_XBF16) unpack8f(cur.xb[j], xo[2 * j], xo[2 * j + 1]); else { xo[2 * j] = cur.x[2 * j]; xo[2 * j + 1] = cur.x[2 * j + 1]; } }
#pragma unroll
                for (int j = 0; j < 8; ++j) ss += (f[j][0] * f[j][0] + f[j][1] * f[j][1]) + (f[j][2] * f[j][2] + f[j][3] * f[j][3]);
                const float rstd = rsqrtf(wave_sum(ss) * (1.0f / DM) + NORM_EPS);
#pragma unroll
                for (int j = 0; j < 8; ++j) { const int c = 8 * lane + 512 * (j >> 1) + 4 * (j & 1); const f32x4 gg = *(const LAS f32x4*)(VG + c); x[j] = xo[j] + gg * (f[j] * rstd); }
            }
            if (XOUT_BF) {
#pragma unroll
                for (int j = 0; j < 4; ++j) { v4u o; o.x = pk2(x[2 * j][0], x[2 * j][1]); o.y = pk2(x[2 * j][2], x[2 * j][3]); o.z = pk2(x[2 * j + 1][0], x[2 * j + 1][1]); o.w = pk2(x[2 * j + 1][2], x[2 * j + 1][3]);
                    *(v4u*)(XB + (size_t)row * DM + 8 * lane + 512 * j) = o; }
            } else {
#pragma unroll
                for (int j = 0; j < 8; ++j) { if (MK_XBF16) __builtin_nontemporal_store(x[j], (f32x4*)(X + (size_t)row * DM + 8 * lane + 512 * (j >> 1) + 4 * (j & 1))); else *(f32x4*)(X + (size_t)row * DM + 8 * lane + 512 * (j >> 1) + 4 * (j & 1)) = x[j]; }
            }
            if (HAS_H) {
                float ss = 0.f;
#pragma unroll
                for (int j = 0; j < 8; ++j) ss += (x[j][0] * x[j][0] + x[j][1] * x[j][1]) + (x[j][2] * x[j][2] + x[j][3] * x[j][3]);
                const float rstd = rsqrtf(wave_sum(ss) * (1.0f / DM) + NORM_EPS);
#pragma unroll
                for (int j = 0; j < 4; ++j) { const int c = 8 * lane + 512 * j; f32x4 h[2];
#pragma unroll
                    for (int kk = 0; kk < 2; ++kk) { const f32x4 w = *(const LAS f32x4*)(VW + c + 4 * kk), s0 = *(const LAS f32x4*)(VS + c + 4 * kk); h[kk] = (x[2 * j + kk] * rstd) * w + s0; }
                    v4u o; o.x = pk2(h[0][0], h[0][1]); o.y = pk2(h[0][2], h[0][3]); o.z = pk2(h[1][0], h[1][1]); o.w = pk2(h[1][2], h[1][3]); *(v4u*)(H + (size_t)row * DM + c) = o; }
            }
            if (k + 1 < 8) cur = nxt;
        }
        __syncthreads();
    }
}

namespace att {
typedef short s16x4 __attribute__((ext_vector_type(4)));
typedef float f32x16 __attribute__((ext_vector_type(16)));
constexpr int SHM = 16384;
constexpr int L_V = 0, L_K = 2 * SHM, L_WS = 4 * SHM, L_TBL = L_WS + 2048, L_END = L_TBL + (64 + 480 + 64) * 4;
constexpr int OST_PITCH = 272, L_OST = 73728, OST_WAVE = 32 * OST_PITCH;
static_assert(L_END <= L_OST && L_OST + 8 * OST_WAVE <= LDSCTL_OFF, "attention LDS");
#define KSWZ(row, colB) ((row) * 256 + ((colB) ^ (((row) & 7) << 4)))
#define SBAR() __builtin_amdgcn_sched_barrier(0)
__device__ __forceinline__ int v_st(int k, int c) { const int kk = (k & ~0xC) | ((k & 4) << 1) | ((k & 8) >> 1); return ((kk >> 3) * 4 + (c >> 5)) * 512 + ((kk & 7) * 32 + (c & 31)) * 2; }
__device__ __forceinline__ int v_rd_base(int lane) { return ((lane & 3) << 3) | (((lane >> 2) & 3) << 6) | (((lane >> 4) & 1) << 5) | (((lane >> 5) & 1) << 8); }
constexpr int v_rd_off(int d0, int ks, int half) { return d0 * 512 + ks * 4096 + half * 2048; }
__device__ __forceinline__ int crow(int r, int hi) { return (r & 3) + 8 * (r >> 2) + 4 * hi; }
__device__ __forceinline__ unsigned cvtpk(float lo, float hi) { unsigned r; asm volatile("v_cvt_pk_bf16_f32 %0, %1, %2" : "=v"(r) : "v"(lo), "v"(hi)); return r; }
__device__ __forceinline__ void rope_pair(bf16x8& a, bf16x8& b, const float* rp) {
    const v4u wa = __builtin_bit_cast(v4u, a), wb = __builtin_bit_cast(v4u, b);
    const float x1[8] = {bflo(wa.x), bfhi(wa.x), bflo(wa.y), bfhi(wa.y), bflo(wa.z), bfhi(wa.z), bflo(wa.w), bfhi(wa.w)};
    const float x2[8] = {bflo(wb.x), bfhi(wb.x), bflo(wb.y), bfhi(wb.y), bflo(wb.z), bfhi(wb.z), bflo(wb.w), bfhi(wb.w)};
    const f32x4 c0 = *(const f32x4*)rp, c1 = *(const f32x4*)(rp + 4), c2 = *(const f32x4*)(rp + 8), c3 = *(const f32x4*)(rp + 12);
    const float cs[16] = {c0[0], c0[1], c0[2], c0[3], c1[0], c1[1], c1[2], c1[3], c2[0], c2[1], c2[2], c2[3], c3[0], c3[1], c3[2], c3[3]};
    float y1[8], y2[8];
#pragma unroll
    for (int e = 0; e < 8; ++e) { const float c = cs[2 * e], s = cs[2 * e + 1]; y1[e] = x1[e] * c - x2[e] * s; y2[e] = x1[e] * s + x2[e] * c; }
    v4u oa, ob; oa.x = cvtpk(y1[0], y1[1]); oa.y = cvtpk(y1[2], y1[3]); oa.z = cvtpk(y1[4], y1[5]); oa.w = cvtpk(y1[6], y1[7]);
    ob.x = cvtpk(y2[0], y2[1]); ob.y = cvtpk(y2[2], y2[3]); ob.z = cvtpk(y2[4], y2[5]); ob.w = cvtpk(y2[6], y2[7]);
    a = __builtin_bit_cast(bf16x8, oa); b = __builtin_bit_cast(bf16x8, ob);
}
__device__ __forceinline__ void qkt(f32x16& p0, f32x16& p1, const LAS unsigned char* Kt, int kq0, int kq1, int kq2, int kq3, const bf16x8* qr) {
    p0 = f32x16{}; p1 = f32x16{};
    const LAS unsigned char* kb[4] = {Kt + kq0, Kt + kq1, Kt + kq2, Kt + kq3};
#pragma unroll
    for (int d0 = 0; d0 < 8; ++d0) { const LAS unsigned char* ap = kb[d0 & 3] + (d0 >> 2) * 128;
        const bf16x8 b0 = *(const LAS bf16x8*)ap;
        const bf16x8 b1 = *(const LAS bf16x8*)(ap + 32 * 256);
        p0 = __builtin_amdgcn_mfma_f32_32x32x16_bf16(b0, qr[d0], p0, 0, 0, 0);
        p1 = __builtin_amdgcn_mfma_f32_32x32x16_bf16(b1, qr[d0], p1, 0, 0, 0); }
}
__device__ __forceinline__ void pv_tile(f32x16* o, int vb0, bf16x8 pa0, bf16x8 pa1, bf16x8 pa2, bf16x8 pa3) {
#define TRRD(dst, off) asm volatile("ds_read_b64_tr_b16 %0, %1 offset:%2" : "=&v"(dst) : "v"(vb0), "i"(off) : "memory")
#define PV_RD(S, d0) do { constexpr int b_ = v_rd_off(d0, 0, 0); TRRD(S##l0, b_); TRRD(S##h0, b_ + 2048); TRRD(S##l1, b_ + 4096); TRRD(S##h1, b_ + 6144); TRRD(S##l2, b_ + 8192); TRRD(S##h2, b_ + 10240); TRRD(S##l3, b_ + 12288); TRRD(S##h3, b_ + 14336); } while (0)
#define PV_MM(S, d0) do { \
        o[d0] = __builtin_amdgcn_mfma_f32_32x32x16_bf16(pa0, (bf16x8){S##l0[0], S##l0[1], S##l0[2], S##l0[3], S##h0[0], S##h0[1], S##h0[2], S##h0[3]}, o[d0], 0, 0, 0); \
        o[d0] = __builtin_amdgcn_mfma_f32_32x32x16_bf16(pa1, (bf16x8){S##l1[0], S##l1[1], S##l1[2], S##l1[3], S##h1[0], S##h1[1], S##h1[2], S##h1[3]}, o[d0], 0, 0, 0); \
        o[d0] = __builtin_amdgcn_mfma_f32_32x32x16_bf16(pa2, (bf16x8){S##l2[0], S##l2[1], S##l2[2], S##l2[3], S##h2[0], S##h2[1], S##h2[2], S##h2[3]}, o[d0], 0, 0, 0); \
        o[d0] = __builtin_amdgcn_mfma_f32_32x32x16_bf16(pa3, (bf16x8){S##l3[0], S##l3[1], S##l3[2], S##l3[3], S##h3[0], S##h3[1], S##h3[2], S##h3[3]}, o[d0], 0, 0, 0); } while (0)
    s16x4 Al0, Al1, Al2, Al3, Ah0, Ah1, Ah2, Ah3, Bl0, Bl1, Bl2, Bl3, Bh0, Bh1, Bh2, Bh3;
    PV_RD(A, 0); PV_RD(B, 1);
    asm volatile("s_waitcnt lgkmcnt(8)" ::: "memory"); SBAR(); PV_MM(A, 0); SBAR();
    PV_RD(A, 2);
    asm volatile("s_waitcnt lgkmcnt(8)" ::: "memory"); SBAR(); PV_MM(B, 1); SBAR();
    PV_RD(B, 3);
    asm volatile("s_waitcnt lgkmcnt(8)" ::: "memory"); SBAR(); PV_MM(A, 2); SBAR();
    asm volatile("s_waitcnt lgkmcnt(0)" ::: "memory"); SBAR(); PV_MM(B, 3);
#undef PV_MM
#undef PV_RD
#undef TRRD
}
constexpr int N_UNITS = 768, N_GMLP = 512;
#define LAUNDER(v) asm volatile("" : "+v"(v))
__device__ __forceinline__ void attn_unit(const Args& a, int l, int u, LAS unsigned char* lds, int wid, int lane_in) {
    int mode, b, head, qb = 0;
    if (u < 384) { const int v = u % 96, k = u / 96; mode = 2 + (k & 1); b = v / 12; head = (v % 12) >> 1; qb = k < 2 ? 1 + (v & 1) : ((v & 1) ? 3 : 0); }
    else if (u < 576) { const int v = u - 384; mode = 0; b = v / 6; head = v % 6; }
    else { const int v = u - 576; mode = 1; b = v / 6; head = v % 6; }
    const bool lat = mode >= 2, mixB = (mode & 1) != 0;
    const int g = head / 3;
    const int qcol = mixB ? QB_ + head * 128 : QA_ + head * 128, kcol = mixB ? KB_ + g * 128 : KA_ + head * 128, vcol = mixB ? VB_ + g * 128 : VA_ + head * 128;
    const int seq0 = lat ? NCTX + b * 1024 : b * 256, row0 = seq0 + qb * 256;
    const bf16* Z = (const bf16*)(a.ws + WS_Z); const float* rope = (const float*)(a.ws + WS_ROPE);
    const char *K1, *V1, *K2 = nullptr, *V2 = nullptr; int s1, n2 = 0, j2 = 0;
    if (!lat) { K1 = (const char*)(Z + (size_t)seq0 * INW + kcol); V1 = (const char*)(Z + (size_t)seq0 * INW + vcol); s1 = INW; }
    else {
        if (!mixB) { const size_t co = (size_t)((b * 4 + l) * 6 + head) * 256 * 128; K1 = (const char*)((const bf16*)(a.ws + WS_CAK) + co); V1 = (const char*)((const bf16*)(a.ws + WS_CAV) + co); }
        else { const size_t co = (size_t)((b * 4 + l) * 2 + g) * 256 * 128; K1 = (const char*)((const bf16*)(a.ws + WS_CBK) + co); V1 = (const char*)((const bf16*)(a.ws + WS_CBV) + co); }
        s1 = 128; K2 = (const char*)(Z + (size_t)seq0 * INW + kcol); V2 = (const char*)(Z + (size_t)seq0 * INW + vcol);
        if (!mixB) { j2 = qb <= 1 ? 0 : (qb == 2 ? 4 : 8); n2 = (qb == 0 || qb == 3) ? 8 : 11; }
        else { j2 = 4 * qb - 2 < 0 ? 0 : 4 * qb - 2; const int je = 4 * qb + 6 > 16 ? 16 : 4 * qb + 6; n2 = je - j2; }
    }
    const int NT = 4 + n2;
    LAS unsigned char* V_lds = lds + L_V; LAS unsigned char* K_lds = lds + L_K;
    LAS float* tbl = (LAS float*)(lds + L_TBL) + 64;
    bf16x8 st_k0, st_k1, st_v0, st_v1;
#define A_LOAD(t) do { const char* kp_; const char* vp_; unsigned of_; \
        if ((t) < 4) { kp_ = K1 + (size_t)(t) * 64 * s1 * 2; vp_ = V1 + (size_t)(t) * 64 * s1 * 2; of_ = of1; } \
        else { kp_ = K2 + (size_t)(j2 + (t) - 4) * 64 * INW * 2; vp_ = V2 + (size_t)(j2 + (t) - 4) * 64 * INW * 2; of_ = of2; } \
        st_k0 = *(const bf16x8*)(kp_ + of_); st_k1 = *(const bf16x8*)(kp_ + of_ + 64); st_v0 = *(const bf16x8*)(vp_ + of_); st_v1 = *(const bf16x8*)(vp_ + of_ + 64); } while (0)
    int lnu = lane_in; LAUNDER(lnu);
    const int tid_u = wid * 64 + lnu, sk_u = tid_u >> 3, cg_u = tid_u & 7, c1_u = (cg_u >> 2) * 8 + (cg_u & 3), r32 = lnu & 31, hi = lnu >> 5;
    const int kw0 = KSWZ(sk_u, c1_u * 16), kw1 = KSWZ(sk_u, (c1_u + 4) * 16), vw0 = v_st(sk_u, c1_u * 8), vw1 = v_st(sk_u, c1_u * 8 + 32);
    const unsigned of1 = (unsigned)(sk_u * s1 + c1_u * 8) * 2u, of2 = (unsigned)(sk_u * INW + c1_u * 8) * 2u;
    const int kq0 = KSWZ(r32, (0 * 16 + hi * 8) * 2), kq1 = KSWZ(r32, (1 * 16 + hi * 8) * 2), kq2 = KSWZ(r32, (2 * 16 + hi * 8) * 2), kq3 = KSWZ(r32, (3 * 16 + hi * 8) * 2);
    const int vrb = (int)(uintptr_t)V_lds + v_rd_base(lnu);
    bf16x8 qr[8];
    { const int ln = lnu;
      const char* qp = (const char*)(Z + (size_t)(row0 + wid * 32) * INW + qcol); const unsigned qo = (unsigned)(r32 * INW + hi * 8) * 2u;
#pragma unroll
      for (int d0 = 0; d0 < 8; ++d0) qr[d0] = *(const bf16x8*)(qp + qo + d0 * 32);
      A_LOAD(0);
      if (mode == 3) { const int t = qb * 256 + wid * 32 + r32; const float* rp0 = rope + ((t >> 6) * 32 + hi * 8) * 2; const float* rp1 = rope + ((t & 63) * 32 + hi * 8) * 2;
          rope_pair(qr[0], qr[2], rp0); rope_pair(qr[1], qr[3], rp0 + 32); rope_pair(qr[4], qr[6], rp1); rope_pair(qr[5], qr[7], rp1 + 32); }
      if (mode == 2) { const int tid = wid * 64 + ln; if (tid < 480) { const int ir = tid >> 5, ic = tid & 31; tbl[tid] = ic < 31 ? a.in[I_RPB][((l * 6 + head) * 15 + ir) * 31 + ic] * 11.313708498984761f : 0.f; } } }
    float m_reg = -1e30f, l_reg = 0.f;
    if (mixB) { m_reg = a.in[I_SINK][l * 6 + head] * 11.313708498984761f; l_reg = 1.f; }
    f32x16 o[4] = {};
    const int qlo = qb * 256 + wid * 32;
    const int rq = 4 * qb + (wid >> 1);
    int stA = rq - 4; stA = stA < 0 ? 0 : (stA > 8 ? 8 : stA);
    constexpr float C2 = 1.4426950408889634f * ATT_SCALE;
    for (int t = 0; t < NT; ++t) {
        const int buf = t & 1;
        const bool local = lat && t >= 4; const int j = j2 + t - 4;
        { if (local && mixB) { const float* rp = rope + (((cg_u >> 2) ? sk_u : j) * 32 + (cg_u & 3) * 8) * 2; rope_pair(st_k0, st_k1, rp); }
          *(LAS bf16x8*)(K_lds + buf * SHM + kw0) = st_k0; *(LAS bf16x8*)(K_lds + buf * SHM + kw1) = st_k1;
          *(LAS bf16x8*)(V_lds + buf * SHM + vw0) = st_v0; *(LAS bf16x8*)(V_lds + buf * SHM + vw1) = st_v1; }
        if (t + 1 < NT) A_LOAD(t + 1);
        __syncthreads();
        bool act = true;
        if (local) { if (!mixB) act = (j >= stA) && (j < stA + 8); else act = (64 * j <= qlo + 31 + 128) && (64 * j + 63 >= qlo - 128); }
        if (act) {
            LAS float* al_l = (LAS float*)(lds + L_WS) + wid * 64 + 32;
            f32x16 p0, p1;
            qkt(p0, p1, K_lds + buf * SHM, kq0, kq1, kq2, kq3, qr);
            if (local) {
                const float NEG = -__builtin_inff();
                if (!mixB) {
                    const int cq = 32 * (wid & 1) + r32; int c0 = cq - 8; c0 = c0 < 0 ? 0 : (c0 > 48 ? 48 : c0);
                    const volatile LAS float* trow = tbl + (j - rq + 7) * 32 + (15 - cq) + 4 * hi; const int kb = 4 * hi - c0;
                    float bv[16];
#pragma unroll
                    for (int r = 0; r < 16; ++r) bv[r] = trow[(r & 3) + 8 * (r >> 2)];
#pragma unroll
                    for (int r = 0; r < 16; ++r) { const int kc = (r & 3) + 8 * (r >> 2); p0[r] = ((unsigned)(kc + kb) < 16u) ? p0[r] + bv[r] : NEG; }
#pragma unroll
                    for (int r = 0; r < 16; ++r) bv[r] = trow[(r & 3) + 8 * (r >> 2) + 32];
#pragma unroll
                    for (int r = 0; r < 16; ++r) { const int kc = (r & 3) + 8 * (r >> 2); p1[r] = ((unsigned)(kc + 32 + kb) < 16u) ? p1[r] + bv[r] : NEG; }
                } else {
                    const int dq = 64 * j + 4 * hi - (qlo + r32) + 128;
#pragma unroll
                    for (int r = 0; r < 16; ++r) { const int kc = (r & 3) + 8 * (r >> 2);
                        p0[r] = ((unsigned)(dq + kc) > 256u) ? NEG : p0[r];
                        p1[r] = ((unsigned)(dq + kc + 32) > 256u) ? NEG : p1[r]; }
                }
            }
            float pmax = p0[0];
#pragma unroll
            for (int r = 1; r < 16; ++r) pmax = fmaxf(pmax, p0[r]);
#pragma unroll
            for (int r = 0; r < 16; ++r) pmax = fmaxf(pmax, p1[r]);
            { auto rr = __builtin_amdgcn_permlane32_swap(__float_as_uint(pmax), __float_as_uint(pmax), false, false); pmax = fmaxf(__uint_as_float(rr[0]), __uint_as_float(rr[1])); }
            float mn = m_reg, alpha = 1.f;
            if (!__all((pmax - m_reg) * ATT_SCALE <= 8.0f)) { mn = fmaxf(m_reg, pmax); alpha = __builtin_amdgcn_exp2f((m_reg - mn) * C2); m_reg = mn; }
            const float mnL = -mn * C2;
            float ps = 0.f;
#pragma unroll
            for (int r = 0; r < 16; ++r) { p0[r] = __builtin_amdgcn_exp2f(fmaf(p0[r], C2, mnL)); p1[r] = __builtin_amdgcn_exp2f(fmaf(p1[r], C2, mnL)); ps += p0[r] + p1[r]; }
            { auto rr = __builtin_amdgcn_permlane32_swap(__float_as_uint(ps), __float_as_uint(ps), false, false); ps = __uint_as_float(rr[0]) + __uint_as_float(rr[1]); }
            l_reg = l_reg * alpha + ps;
            if (__any(alpha < 1.f)) { if (hi == 0) al_l[r32] = alpha; asm volatile("s_waitcnt lgkmcnt(0)" ::: "memory");
#pragma unroll
                for (int r = 0; r < 16; ++r) { const float av = al_l[crow(r, hi)];
#pragma unroll
                    for (int d_ = 0; d_ < 4; ++d_) o[d_][r] *= av; } }
            bf16x8 pa0, pa1, pa2, pa3;
#define PK4(P, B_, OUT) do { unsigned a0 = cvtpk(P[B_ + 0], P[B_ + 1]), a1 = cvtpk(P[B_ + 2], P[B_ + 3]); unsigned b0 = cvtpk(P[B_ + 4], P[B_ + 5]), b1 = cvtpk(P[B_ + 6], P[B_ + 7]); \
        auto r0 = __builtin_amdgcn_permlane32_swap(a0, b0, false, false); auto r1 = __builtin_amdgcn_permlane32_swap(a1, b1, false, false); \
        v4u w = {r0[0], r1[0], r0[1], r1[1]}; OUT = __builtin_bit_cast(bf16x8, w); } while (0)
            PK4(p0, 0, pa0); PK4(p0, 8, pa1); PK4(p1, 0, pa2); PK4(p1, 8, pa3);
#undef PK4
            pv_tile(o, vrb + buf * SHM, pa0, pa1, pa2, pa3);
        }
    }
#undef A_LOAD
    { int ln = lane_in; LAUNDER(ln); const int r32 = ln & 31, hi = ln >> 5;
      LAS float* li_l = (LAS float*)(lds + L_WS) + wid * 64;
      if (hi == 0) li_l[r32] = l_reg; asm volatile("s_waitcnt lgkmcnt(0)" ::: "memory");
      LAS unsigned char* ost = lds + L_OST + wid * OST_WAVE;
#pragma unroll
      for (int r = 0; r < 16; ++r) { const int orow0 = (r & 3) + 8 * (r >> 2); const float rl = __builtin_amdgcn_rcpf(li_l[orow0 + 4 * hi]);
#pragma unroll
          for (int d0 = 0; d0 < 4; ++d0) *(LAS unsigned short*)(ost + (orow0 + 4 * hi) * OST_PITCH + (d0 * 32 + r32) * 2) = (unsigned short)f2bf(o[d0][r] * rl); }
      asm volatile("s_waitcnt lgkmcnt(0)" ::: "memory");
      char* Ow = (char*)((bf16*)(a.ws + WS_MRG) + (size_t)(row0 + wid * 32) * DM + (mixB ? 768 : 0) + head * 128);
#pragma unroll
      for (int i = 0; i < 8; ++i) { const int row = (ln >> 4) + 4 * i; const v4u w = *(const LAS v4u*)(ost + row * OST_PITCH + (ln & 15) * 16);
          *(v4u*)(Ow + (size_t)row * DM * 2 + (ln & 15) * 16) = w; } }
    __syncthreads();
}
#undef LAUNDER
#undef KSWZ
#undef SBAR

constexpr int GT_PITCH = 136;
__device__ __forceinline__ void gmlp_unit(const Args& a, int l, int unit, LAS unsigned char* lds, int tid, int wave, int lane) {
    const int n = unit >> 2, g = unit & 3, R0 = n * 128;
    const bf16* Z = (const bf16*)(a.ws + WS_Z); bf16* MR = (bf16*)(a.ws + WS_MRG);
    LAS unsigned short* T = (LAS unsigned short*)lds;
    LAS float* ST = (LAS float*)(lds + 128 * GT_PITCH * 2);
    const int fi = lane & 15, kg = lane >> 4, p = wave * 16 + fi;
    bf16x8 wf[4];
    { const float* W = a.in[I_GW] + (size_t)((l * 4 + g) * 128 + p) * 128 + 8 * kg;
#pragma unroll
      for (int ks = 0; ks < 4; ++ks) { const f32x4 x0 = *(const f32x4*)(W + 32 * ks), x1 = *(const f32x4*)(W + 32 * ks + 4);
          v4u w; w.x = att::cvtpk(x0[0], x0[1]); w.y = att::cvtpk(x0[2], x0[3]); w.z = att::cvtpk(x1[0], x1[1]); w.w = att::cvtpk(x1[2], x1[3]); wf[ks] = __builtin_bit_cast(bf16x8, w); } }
    { const int q = tid >> 2, cp = tid & 3; const bf16* zp = Z + (size_t)(R0 + q) * INW + VC_ + cp * 8; v4u vw[16];
#pragma unroll
      for (int i = 0; i < 16; ++i) vw[i] = *(const v4u*)(zp + i * 32);
      float s = 0.f, s2 = 0.f;
#pragma unroll
      for (int i = 0; i < 16; ++i) { const v4u w = vw[i]; const float v[8] = {bflo(w.x), bfhi(w.x), bflo(w.y), bfhi(w.y), bflo(w.z), bfhi(w.z), bflo(w.w), bfhi(w.w)};
#pragma unroll
          for (int e = 0; e < 8; ++e) { s += v[e]; s2 += v[e] * v[e]; } }
      s += __shfl_xor(s, 1); s2 += __shfl_xor(s2, 1); s += __shfl_xor(s, 2); s2 += __shfl_xor(s2, 2);
      const float mean = s * (1.0f / 512.0f), var = s2 * (1.0f / 512.0f) - mean * mean;
      if (cp == 0) { ST[q * 2] = mean; ST[q * 2 + 1] = rsqrtf(var + NORM_EPS); } }
    __syncthreads();
    { const int q = tid >> 2, cp = tid & 3; const float mean = ST[q * 2], rstd = ST[q * 2 + 1];
      const bf16* zp = Z + (size_t)(R0 + q) * INW + VC_ + g * 128 + cp * 32; const float* lg = a.in[I_LNG] + l * 512 + g * 128 + cp * 32; const float* lb = a.in[I_LNB] + l * 512 + g * 128 + cp * 32;
#pragma unroll
      for (int c8 = 0; c8 < 4; ++c8) { const v4u w = *(const v4u*)(zp + c8 * 8);
          const float v[8] = {bflo(w.x), bfhi(w.x), bflo(w.y), bfhi(w.y), bflo(w.z), bfhi(w.z), bflo(w.w), bfhi(w.w)};
#pragma unroll
          for (int e = 0; e < 8; ++e) { const int c = cp * 32 + c8 * 8 + e; const float y = (v[e] - mean) * rstd * lg[c8 * 8 + e] + lb[c8 * 8 + e]; T[c * GT_PITCH + q] = (unsigned short)f2bf(y); } } }
    __syncthreads();
    f32x4 acc[8];
#pragma unroll
    for (int cb = 0; cb < 8; ++cb) acc[cb] = (f32x4){0.f, 0.f, 0.f, 0.f};
#pragma unroll
    for (int cb = 0; cb < 8; ++cb)
#pragma unroll
        for (int ks = 0; ks < 4; ++ks) { const bf16x8 af = *(const LAS bf16x8*)(T + (cb * 16 + fi) * GT_PITCH + 32 * ks + 8 * kg);
            acc[cb] = __builtin_amdgcn_mfma_f32_16x16x32_bf16(af, wf[ks], acc[cb], 0, 0, 0); }
    const float bs = a.in[I_GB][(l * 4 + g) * 128 + p];
#pragma unroll
    for (int cb = 0; cb < 8; ++cb) { const int ch = g * 128 + cb * 16 + 4 * kg; const v2u uw = *(const v2u*)(Z + (size_t)(R0 + p) * INW + UC_ + ch);
        v2u ow; ow.x = att::cvtpk(bflo(uw.x) * (acc[cb][0] + bs), bfhi(uw.x) * (acc[cb][1] + bs)); ow.y = att::cvtpk(bflo(uw.y) * (acc[cb][2] + bs), bfhi(uw.y) * (acc[cb][3] + bs));
        *(v2u*)(MR + (size_t)(R0 + p) * DM + 1536 + ch) = ow; }
    __syncthreads();
}
}
constexpr int N_PHASES = 2 + 7 * DEPTH;
#ifndef MK_SP2
#define MK_SP2 true
#endif
#ifndef MK_ALIGN
#define MK_ALIGN true
#endif
#ifndef MK_REP_T0
#define MK_REP_T0 1
#endif
#ifndef MK_REP_P0
#define MK_REP_P0 1
#endif
#ifndef MK_REP_G1
#define MK_REP_G1 1
#endif
#ifndef MK_REP_MIX
#define MK_REP_MIX 1
#endif
#ifndef MK_REP_G2
#define MK_REP_G2 1
#endif
#ifndef MK_REP_G3
#define MK_REP_G3 1
#endif
#ifndef MK_REP_G4
#define MK_REP_G4 1
#endif
__global__ void __launch_bounds__(NWAVES * 64, 2) fwd_kernel(Args args) {
    extern __shared__ __attribute__((aligned(16))) unsigned char lds_raw[];
    LAS unsigned char* lds = (LAS unsigned char*)lds_raw;
    volatile LAS unsigned* MISC = (volatile LAS unsigned*)(lds + MISC_OFF);
    const int tid = threadIdx.x, G = gridDim.x; const int wave_s = __builtin_amdgcn_readfirstlane(tid >> 6);
    unsigned* ctl = (unsigned*)(args.ws + WS_CTL);
    for (int u = tid; u < (LDS_BYTES - LDSCTL_OFF) / 4; u += NWAVES * 64) ((LAS unsigned*)(lds + LDSCTL_OFF))[u] = 0u;
    __syncthreads();
    XcdBarrier bar = xcd_barrier_post(ctl + CW_BAR, MISC + 8);
    const int lo = args.ph_lo, hi = args.ph_hi;
#define IN(k) (lo <= (k) && (k) < hi)
#define PHASE_IDS() int lane_p = (int)__builtin_amdgcn_mbcnt_hi(~0u, __builtin_amdgcn_mbcnt_lo(~0u, 0u)); asm volatile("" : "+v"(lane_p)); const int wave_p = wave_s, tid_p = wave_s * 64 + lane_p; (void)tid_p; (void)wave_p
#ifndef MK_WGM_G2
#define MK_WGM_G2 4
#endif
#ifndef MK_WGM_G4
#define MK_WGM_G4 4
#endif
#ifndef MK_WS_TOP
#define MK_WS_TOP 1
#endif
#ifndef MK_REP_SEAM
#define MK_REP_SEAM 0
#endif
#ifndef MK_REP_BAR
#define MK_REP_BAR 1
#endif
#define SEAM(k) do { if ((k) + 1 < hi) { for (int rb_ = 0; rb_ < MK_REP_BAR; ++rb_) xcd_barrier(bar); } } while (0)

    if (IN(0)) { for (int rep = 0; rep < MK_REP_P0; ++rep) { PHASE_IDS(); p0_prologue(args, lds, tid_p, wave_p, lane_p, G); __syncthreads(); } SEAM(0); }
    if (IN(1)) { for (int rep = 0; rep < MK_REP_T0; ++rep) { PHASE_IDS(); thin_phase<0, true>(args, lds, tid_p, wave_p, lane_p, G, nullptr, 0, 0, args.in[I_NMPRE], 1, 0, 0); } SEAM(1); }

    for (int l = 0; l < DEPTH; ++l) {
        const int pb = 2 + 7 * l;
        if (IN(pb + 0)) {
            pg8::Gemm g{(const pg8::bf16_t*)(args.ws + WS_H), (const pg8::bf16_t*)(args.ws + WS_WIN) + (size_t)l * INW * DM, MROWS, INW, DM};
            pg8::StaticOrder S; S.init(MROWS, INW, G, (int)blockIdx.x);
            pg8::EpiWin E{(pg8::bf16_t*)(args.ws + WS_Z), args.out, l};
            for (int rep = 0; rep < MK_REP_G1; ++rep)
            pg8::gemm_phase<pg8::EpiWin, pg8::StaticOrder, MK_ALIGN, MK_SP2>(lds + RING_OFF, g, S, E, wave_s);
            if (MK_CONV_TAIL && l + 1 < DEPTH) { constexpr int total = (MROWS / 256) * (INW / 256); const int rounds = (total + G - 1) / G, nshort = rounds * G - total, c = (int)blockIdx.x;
                if (nshort == 0) { PHASE_IDS(); p0_convert_layer(args, l + 1, lds, wave_p, lane_p, wave_p * G + c, G * NWAVES, 0, MK_CONV_TAIL); }
                else if (c >= G - nshort) { PHASE_IDS(); p0_convert_layer(args, l + 1, lds, wave_p, lane_p, wave_p * nshort + (c - (G - nshort)), nshort * NWAVES, 0, MK_CONV_TAIL); } }
            SEAM(pb + 0);
        }
        if (IN(pb + 1)) {
            PHASE_IDS();
            for (int rep = 0; rep < MK_REP_MIX; ++rep) {
                unsigned* qctr = ctl + CW_QUEUE + 64 * (l + 4 * rep); volatile LAS unsigned* qw = MISC + 16;
                unsigned tk = 0;
                if (tid_p == 0) qw[0] = __hip_atomic_fetch_add(qctr, 1u, __ATOMIC_RELAXED, __HIP_MEMORY_SCOPE_AGENT);
                __syncthreads(); tk = (unsigned)__builtin_amdgcn_readfirstlane((int)qw[0]); __syncthreads();
                while (tk < (unsigned)att::N_UNITS) {
                    unsigned nx = 0; if (tid_p == 0) nx = __hip_atomic_fetch_add(qctr, 1u, __ATOMIC_RELAXED, __HIP_MEMORY_SCOPE_AGENT);
                    att::attn_unit(args, l, (int)tk, lds + RING_OFF, wave_p, lane_p);
                    if (tid_p == 0) qw[0] = nx;
                    __syncthreads(); tk = (unsigned)__builtin_amdgcn_readfirstlane((int)qw[0]); __syncthreads();
                }
                while (tk < (unsigned)(att::N_UNITS + att::N_GMLP)) {
                    unsigned nx = 0; if (tid_p == 0) nx = __hip_atomic_fetch_add(qctr, 1u, __ATOMIC_RELAXED, __HIP_MEMORY_SCOPE_AGENT);
                    att::gmlp_unit(args, l, (int)tk - att::N_UNITS, lds + RING_OFF, tid_p, wave_p, lane_p);
                    if (tid_p == 0) qw[0] = nx;
                    __syncthreads(); tk = (unsigned)__builtin_amdgcn_readfirstlane((int)qw[0]); __syncthreads();
                }
            }
            SEAM(pb + 1);
        }
        if (IN(pb + 2)) {
            pg8::Gemm g{(const pg8::bf16_t*)(args.ws + WS_MRG), (const pg8::bf16_t*)(args.ws + WS_WOUT) + (size_t)l * DM * DM, MROWS, DM, DM};
            pg8::StaticOrder S; S.init(MROWS, DM, G, (int)blockIdx.x, MK_WGM_G2);
            pg8::EpiBf16 E{(pg8::bf16_t*)(args.ws + WS_F1), DM};
            for (int rep = 0; rep < MK_REP_G2; ++rep) {
            pg8::gemm_phase<pg8::EpiBf16, pg8::StaticOrder, MK_ALIGN, MK_SP2>(lds + RING_OFF, g, S, E, wave_s);
            if (MK_REP_SEAM && rep + 1 < MK_REP_G2) xcd_barrier(bar); }
            SEAM(pb + 2);
        }
        if (IN(pb + 3)) {
            PHASE_IDS(); thin_phase<1, true>(args, lds, tid_p, wave_p, lane_p, G, args.in[I_NMPOST] + l * DM, 2, l, args.in[I_NFPRE] + l * DM, 4, 3, l);
            SEAM(pb + 3);
        }
        if (IN(pb + 4)) {
            pg8::Gemm g{(const pg8::bf16_t*)(args.ws + WS_H), (const pg8::bf16_t*)(args.ws + WS_WGU) + (size_t)l * NGU * DM, MROWS, NGU, DM};
            pg8::StaticOrder S; S.init(MROWS, NGU, G, (int)blockIdx.x);
            pg8::EpiGU E{(pg8::bf16_t*)(args.ws + WS_ACT)};
            for (int rep = 0; rep < MK_REP_G3; ++rep)
            pg8::gemm_phase<pg8::EpiGU, pg8::StaticOrder, MK_ALIGN, MK_SP2>(lds + RING_OFF, g, S, E, wave_s);
            SEAM(pb + 4);
        }
        if (IN(pb + 5)) {
            pg8::Gemm g{(const pg8::bf16_t*)(args.ws + WS_ACT), (const pg8::bf16_t*)(args.ws + WS_WDN) + (size_t)l * DM * DFF, MROWS, DM, DFF};
            pg8::StaticOrder S; S.init(MROWS, DM, G, (int)blockIdx.x, MK_WGM_G4);
            pg8::EpiBf16 E{(pg8::bf16_t*)(args.ws + WS_F2), DM};
            for (int rep = 0; rep < MK_REP_G4; ++rep)
            pg8::gemm_phase<pg8::EpiBf16, pg8::StaticOrder, MK_ALIGN, MK_SP2>(lds + RING_OFF, g, S, E, wave_s);
            SEAM(pb + 5);
        }
        if (IN(pb + 6)) {
            PHASE_IDS();
            if (l + 1 < DEPTH) thin_phase<1, true>(args, lds, tid_p, wave_p, lane_p, G, args.in[I_NFPOST] + l * DM, 5, l, args.in[I_NMPRE] + (l + 1) * DM, 1, 0, l + 1);
            else thin_phase<1, false>(args, lds, tid_p, wave_p, lane_p, G, args.in[I_NFPOST] + l * DM, 5, l, nullptr, 0, 0, 0);
            SEAM(pb + 6);
        }
    }
#undef IN
#undef SEAM
}

#ifndef MK_LAUNCH_MODE
#define MK_LAUNCH_MODE 0
#endif
extern "C" void kernel_launch(void* const* d_in, const int* in_sizes, int n_in, void* d_out, int out_size, void* d_ws, size_t ws_size, hipStream_t stream) {
    static int grid = 0;
    if (grid == 0) {
        if (n_in != N_IN || (size_t)out_size != O_END || ws_size < WS_END) { fprintf(stderr, "kernel_launch: unexpected shapes: n_in %d out %d ws %zu\n", n_in, out_size, ws_size); grid = -1; return; }
        int dev = 0, cus = 0, per_cu = 0;
        if (hipGetDevice(&dev) != hipSuccess || hipDeviceGetAttribute(&cus, hipDeviceAttributeMultiprocessorCount, dev) != hipSuccess) { fprintf(stderr, "kernel_launch: device query failed\n"); grid = -1; return; }
        if (hipFuncSetAttribute((const void*)fwd_kernel, hipFuncAttributeMaxDynamicSharedMemorySize, LDS_BYTES) != hipSuccess) { fprintf(stderr, "kernel_launch: hipFuncSetAttribute failed\n"); grid = -1; return; }
        if (hipOccupancyMaxActiveBlocksPerMultiprocessor(&per_cu, (const void*)fwd_kernel, NWAVES * 64, LDS_BYTES) != hipSuccess || per_cu < 1)
            fprintf(stderr, "kernel_launch: note: occupancy query reports %d workgroups per CU\n", per_cu);
        (void)hipGetLastError();
        grid = cus;
    }
    if (grid < 0) return;
    const size_t ws_shift = MK_WS_TOP ? ((ws_size - WS_END) & ~(size_t)(2 * MiB - 1)) : 0;
    if (hipMemsetAsync((char*)d_ws + ws_shift + WS_CTL, 0, CTL_ZERO_BYTES, stream) != hipSuccess) { fprintf(stderr, "kernel_launch: memset failed\n"); return; }
    Args a{};
    for (int i = 0; i < N_IN; ++i) a.in[i] = (const float*)d_in[i];
    a.out = (float*)d_out; a.ws = (unsigned char*)d_ws + ws_shift;
#if MK_LAUNCH_MODE == 1
    a.ph_lo = 0; a.ph_hi = N_PHASES;
    hipLaunchKernelGGL(fwd_kernel, dim3(grid), dim3(NWAVES * 64), LDS_BYTES, stream, a);
#else
    for (int p = 0; p < N_PHASES; ++p) { a.ph_lo = p; a.ph_hi = p + 1;
        hipLaunchKernelGGL(fwd_kernel, dim3(grid), dim3(NWAVES * 64), LDS_BYTES, stream, a); }
#endif
    const hipError_t le = hipPeekAtLastError();
    if (le != hipSuccess) fprintf(stderr, "kernel_launch: launch failed: %s\n", hipGetErrorName(le));
}
```

```cpp
#include <hip/hip_runtime.h>
#include <cstdio>
#include <cstdint>
#define MK_LAUNCH_MODE 1
constexpr int DM = 2048, DEPTH = 4, NCTX = 8192, MROWS = 16384, INW = 4608, DFF = 5632, NGU = 11264;
constexpr int QA_ = 0, KA_ = 768, VA_ = 1536, QB_ = 2304, KB_ = 3072, VB_ = 3328, UC_ = 3584, VC_ = 4096;
constexpr float ATT_SCALE = 0.08838834764831845f;
constexpr float NORM_EPS = 1e-6f;
constexpr int NWAVES = 8;
enum { I_XP = 0, I_XS, I_CAK, I_CAV, I_CBK, I_CBV, I_C, I_CCTX, I_MODW, I_MODB, I_NMPRE, I_NMPOST, I_NFPRE, I_NFPOST, I_WIN, I_WOUT, I_RPB, I_SINK, I_LNG, I_LNB, I_GW, I_GB, I_WGATE, I_WUP, I_WDOWN, N_IN };
constexpr size_t O_Y = 0, O_AK = 33554432ull, O_AV = 58720256ull, O_BK = 83886080ull, O_BV = 92274688ull, O_END = 100663296ull;
constexpr size_t MiB = 1u << 20;
constexpr size_t WS_CTL = 0, CTL_ZERO_BYTES = 1 * MiB;
constexpr size_t WS_MOD = 1 * MiB;
constexpr size_t WS_ROPE = 3 * MiB;
constexpr size_t WS_CAK = 4 * MiB, WS_CAV = 16 * MiB, WS_CBK = 28 * MiB, WS_CBV = 32 * MiB;
constexpr size_t WS_WIN = 40 * MiB;
constexpr size_t WS_WOUT = 112 * MiB;
constexpr size_t WS_WGU = 144 * MiB;
constexpr size_t WS_WDN = 320 * MiB;
constexpr size_t WS_A = 408 * MiB, WS_B = 472 * MiB;
constexpr size_t WS_H = WS_A;
constexpr size_t WS_Z = WS_B;
constexpr size_t WS_MRG = WS_A;
constexpr size_t WS_F1 = WS_B;
constexpr size_t WS_F2 = WS_A;
constexpr size_t WS_ACT = WS_B;
constexpr size_t WS_XB = 648 * MiB;
constexpr size_t WS_END = 712 * MiB;
constexpr int CW_BAR = 4096;
constexpr int CW_QUEUE = 16384;
constexpr int RING_OFF = 0, RING_BYTES = 131072;
constexpr int LDSCTL_OFF = 143360, MISC_OFF = LDSCTL_OFF + 320;
constexpr int LDS_BYTES = 147456;
static_assert(MISC_OFF + 128 <= LDS_BYTES, "LDS map");

#define GAS __attribute__((address_space(1)))
#define LAS __attribute__((address_space(3)))
typedef unsigned short bf16;
typedef unsigned v4u __attribute__((ext_vector_type(4)));
typedef unsigned v2u __attribute__((ext_vector_type(2)));
typedef float f32x4 __attribute__((ext_vector_type(4)));
typedef short bf16x8 __attribute__((ext_vector_type(8)));
typedef GAS unsigned gu32;
#define RLX_AGENT __ATOMIC_RELAXED, __HIP_MEMORY_SCOPE_AGENT
#define LDS_WAIT() asm volatile("s_waitcnt lgkmcnt(0)" ::: "memory")
#define VM_WAIT() asm volatile("s_waitcnt vmcnt(0)" ::: "memory")
__device__ __forceinline__ unsigned f2bf(float f) { unsigned u = __builtin_bit_cast(unsigned, f); return (u + 0x7fffu + ((u >> 16) & 1u)) >> 16; }
__device__ __forceinline__ unsigned pk2(float lo, float hi) { return f2bf(lo) | (f2bf(hi) << 16); }
__device__ __forceinline__ float bf2f(unsigned short b) { return __uint_as_float(((unsigned)b) << 16); }
__device__ __forceinline__ float bflo(unsigned w) { return __uint_as_float(w << 16); }
__device__ __forceinline__ float bfhi(unsigned w) { return __uint_as_float(w & 0xffff0000u); }
__device__ __forceinline__ float wave_sum(float v) {
#pragma unroll
    for (int o = 1; o < 64; o <<= 1) v += __shfl_xor(v, o);
    return v;
}
__device__ __forceinline__ float wave_max(float v) {
#pragma unroll
    for (int o = 1; o < 64; o <<= 1) v = fmaxf(v, __shfl_xor(v, o));
    return v;
}
__device__ __forceinline__ float fast_sigmoid(float y) { return __builtin_amdgcn_rcpf(1.0f + __builtin_amdgcn_exp2f(-1.4426950408889634f * y)); }
__device__ __forceinline__ float gelu_tanh(float x) { const float y = 0.7978845608028654f * (x + 0.044715f * x * x * x); return x * fast_sigmoid(2.0f * y); }
__device__ __forceinline__ float silu_f(float x) { return x * fast_sigmoid(x); }
#ifndef MK_WGM
#define MK_WGM 8
#endif
namespace pg8 {
#define PG8_LAS __attribute__((address_space(3)))
typedef unsigned short bf16_t;
typedef short bf16x8 __attribute__((ext_vector_type(8)));
typedef float f32x4 __attribute__((ext_vector_type(4)));
typedef unsigned u32x4 __attribute__((ext_vector_type(4)));
constexpr int BM = 256, BK = 64, HALF = 128, HTB = HALF * BK * 2  , STAGE_BYTES = 8 * HTB, NXCD = 8, WGM = MK_WGM;

__host__ __device__ __forceinline__ int lds_byte(int r, int c) { const int st = (r >> 4) * 2 + (c >> 5), rr = r & 15, cc = c & 31, ob = rr * 64 + cc * 2; return st * 1024 + (ob ^ (((ob >> 9) & 1) << 5)); }
__host__ __device__ __forceinline__ void stage_rc(int b, int& R, int& C) { const int st = b / 1024, sb = b % 1024, swz = sb ^ (((sb >> 9) & 1) << 5); R = (st >> 1) * 16 + swz / 64; C = (st & 1) * 32 + (swz % 64) / 2; }
__host__ __device__ __forceinline__ int perm32(int rho) { const int n = rho >> 4, i = rho & 15; return 8 * (i >> 2) + 4 * n + (i & 3); }

struct Unit { int pm, pn; };
struct Gemm { const bf16_t* A; const bf16_t* Bt; int M, N, K; };

struct StaticOrder {
    int nM, nN, nwg, G, c, wgm;
    __host__ __device__ void init(int M, int N, int G_, int c_, int wgm_ = WGM) { nM = M / BM; nN = N / BM; nwg = nM * nN; G = G_; c = c_; wgm = wgm_; }
    __host__ __device__ bool next(int i, Unit& u) const {
        const long L = (long)i * G + c; if (L >= nwg) return false;
        int wgid = (int)L; { const int q = nwg / NXCD, r = nwg % NXCD, xcd = wgid % NXCD, off = wgid / NXCD; wgid = (xcd < r ? xcd * (q + 1) : r * (q + 1) + (xcd - r) * q) + off; }
        const int nig = wgm * nN, gid = wgid / nig, fm = gid * wgm, gsz = (nM - fm) < wgm ? (nM - fm) : wgm;
        u.pm = fm + ((wgid % nig) % gsz); u.pn = (wgid % nig) / gsz; return true;
    }
    __device__ __forceinline__ void a_ready(const Unit&) const {}
    __device__ __forceinline__ void done(const Unit&) const {}
};
__device__ __forceinline__ unsigned cvt_pk_bf16(float lo, float hi) { unsigned r; asm volatile("v_cvt_pk_bf16_f32 %0, %1, %2" : "=v"(r) : "v"(lo), "v"(hi)); return r; }
typedef float f32x2 __attribute__((ext_vector_type(2)));

struct EpiF32 {
    static constexpr bool PERM = false, AFTER_DRAIN = false;
    float* C; int ldc;
    __device__ __forceinline__ void operator()(const f32x4 (&acc)[2][2][4][2], const Unit& u, int wr, int wc, int fr, int fq) const {
        const int row0 = u.pm * BM + wr * 64 + fr, col0 = u.pn * BM + wc * 32 + 4 * fq;
#pragma unroll
        for (int ai = 0; ai < 2; ++ai)
#pragma unroll
            for (int m = 0; m < 4; ++m) { float* rowp = C + (size_t)(row0 + ai * HALF + m * 16) * ldc + col0;
#pragma unroll
                for (int bj = 0; bj < 2; ++bj)
#pragma unroll
                    for (int n = 0; n < 2; ++n) *(f32x4*)(rowp + bj * HALF + n * 16) = acc[ai][bj][m][n]; }
    }
};
struct EpiWin {
    static constexpr bool PERM = true, AFTER_DRAIN = false;
    bf16_t* Z; float* out; int layer;
    __device__ __forceinline__ void operator()(const f32x4 (&acc)[2][2][4][2], const Unit& u, int wr, int wc, int fr, int fq) const {
        const int row0 = u.pm * BM + wr * 64 + fr, colb = u.pn * BM + wc * 32 + 8 * fq;
        const bool act = u.pn >= 14;
        bool kv = false; size_t kvbase = 0; int nh = 6, h0 = 0;
        if (u.pm < 32) {
            if (u.pn >= 3 && u.pn <= 5)      { kv = true; kvbase = 33554432ull; nh = 6; h0 = 2 * (u.pn - 3); }
            else if (u.pn >= 6 && u.pn <= 8) { kv = true; kvbase = 58720256ull; nh = 6; h0 = 2 * (u.pn - 6); }
            else if (u.pn == 12)             { kv = true; kvbase = 83886080ull; nh = 2; h0 = 0; }
            else if (u.pn == 13)             { kv = true; kvbase = 92274688ull; nh = 2; h0 = 0; }
        }
#pragma unroll
        for (int ai = 0; ai < 2; ++ai)
#pragma unroll
            for (int m = 0; m < 4; ++m) { const int row = row0 + ai * HALF + m * 16; bf16_t* rowp = Z + (size_t)row * 4608 + colb;
#pragma unroll
                for (int bj = 0; bj < 2; ++bj) { f32x4 v0 = acc[ai][bj][m][0], v1 = acc[ai][bj][m][1];
                    if (kv) { float* p = out + kvbase + ((((size_t)u.pm * 4 + layer) * nh + h0 + bj) * 256 + (row - u.pm * BM)) * 128 + wc * 32 + 8 * fq;
                        __builtin_nontemporal_store(v0, (f32x4*)p); __builtin_nontemporal_store(v1, (f32x4*)(p + 4)); }
                    if (act) {
#pragma unroll
                        for (int j = 0; j < 4; ++j) { v0[j] = gelu_tanh(v0[j]); v1[j] = gelu_tanh(v1[j]); } }
                    u32x4 w; w.x = cvt_pk_bf16(v0[0], v0[1]); w.y = cvt_pk_bf16(v0[2], v0[3]); w.z = cvt_pk_bf16(v1[0], v1[1]); w.w = cvt_pk_bf16(v1[2], v1[3]);
                    *(u32x4*)(rowp + bj * HALF) = w; } }
    }
};
struct EpiGU {
    static constexpr bool PERM = true, AFTER_DRAIN = false;
    bf16_t* O;
    __device__ __forceinline__ void operator()(const f32x4 (&acc)[2][2][4][2], const Unit& u, int wr, int wc, int fr, int fq) const {
        const int row0 = u.pm * BM + wr * 64 + fr, col0 = u.pn * HALF + wc * 32 + 8 * fq;
#pragma unroll
        for (int ai = 0; ai < 2; ++ai)
#pragma unroll
            for (int m = 0; m < 4; ++m) { bf16_t* rowp = O + (size_t)(row0 + ai * HALF + m * 16) * 5632 + col0;
                f32x4 v0, v1;
#pragma unroll
                for (int j = 0; j < 4; ++j) { v0[j] = silu_f(acc[ai][0][m][0][j]) * acc[ai][1][m][0][j]; v1[j] = silu_f(acc[ai][0][m][1][j]) * acc[ai][1][m][1][j]; }
                u32x4 w; w.x = cvt_pk_bf16(v0[0], v0[1]); w.y = cvt_pk_bf16(v0[2], v0[3]); w.z = cvt_pk_bf16(v1[0], v1[1]); w.w = cvt_pk_bf16(v1[2], v1[3]);
                *(u32x4*)rowp = w; }
    }
};

struct EpiBf16 {
    static constexpr bool PERM = true, AFTER_DRAIN = false;
    bf16_t* O; int ldc;
    __device__ __forceinline__ void operator()(const f32x4 (&acc)[2][2][4][2], const Unit& u, int wr, int wc, int fr, int fq) const {
        const int row0 = u.pm * BM + wr * 64 + fr, col0 = u.pn * BM + wc * 32 + 8 * fq;
#pragma unroll
        for (int ai = 0; ai < 2; ++ai)
#pragma unroll
            for (int m = 0; m < 4; ++m) { bf16_t* rowp = O + (size_t)(row0 + ai * HALF + m * 16) * ldc + col0;
#pragma unroll
                for (int bj = 0; bj < 2; ++bj) { const f32x4 v0 = acc[ai][bj][m][0], v1 = acc[ai][bj][m][1];
                    u32x4 w; w.x = cvt_pk_bf16(v0[0], v0[1]); w.y = cvt_pk_bf16(v0[2], v0[3]); w.z = cvt_pk_bf16(v1[0], v1[1]); w.w = cvt_pk_bf16(v1[2], v1[3]);
                    *(u32x4*)(rowp + bj * HALF) = w; } }
    }
};
template <class Epi, class Sched, bool ALIGN_EPI = false, bool SP2 = false>
__device__ __forceinline__ void gemm_phase(PG8_LAS unsigned char* lds, const Gemm g, const Sched& S, const Epi& E, const int wave_id  ) {
    int tid_l = (int)__builtin_amdgcn_mbcnt_hi(~0u, __builtin_amdgcn_mbcnt_lo(~0u, 0u)); asm volatile("" : "+v"(tid_l)); tid_l += 64 * wave_id;
    const int tid = tid_l, wid = __builtin_amdgcn_readfirstlane(tid >> 6), lane = tid & 63, wr = wid >> 2, wc = wid & 3, fr = lane & 15, fq = lane >> 4;
    const int K = g.K, nt = K / BK;
    unsigned voffA[2], voffB[2];
#pragma unroll
    for (int i = 0; i < 2; ++i) { int R, C; stage_rc(tid * 16 + i * 8192, R, C); const int Rb = Epi::PERM ? ((R & ~31) + perm32(R & 31)) : R;
        voffA[i] = (unsigned)(R * K + C) * 2u; voffB[i] = (unsigned)(Rb * K + C) * 2u; }
    const size_t kstep = (size_t)(BK * 2);
    const size_t hstep = (size_t)HALF * K * 2;
    const size_t tstep = 2 * hstep;
    const unsigned ldsw = (unsigned)wid * 1024u;
    const int aoff = lds_byte(wr * 64 + fr, fq * 8), boff = lds_byte(wc * 32 + fr, fq * 8);
#define PG8_SA(b, h) (((b) * 2 + (h)) * HTB)
#define PG8_SB(b, h) ((4 + (b) * 2 + (h)) * HTB)
#define PG8_STAGE(bufoff, gbase, voff) do { _Pragma("unroll") for (int _i = 0; _i < 2; ++_i) \
        __builtin_amdgcn_global_load_lds((const unsigned*)((const char*)(gbase) + (voff)[_i]), (PG8_LAS unsigned*)(lds + (bufoff) + ldsw + _i * 8192), 16, 0, 0); } while (0)
#define PG8_LDA(dst, b, h) do { _Pragma("unroll") for (int m = 0; m < 4; ++m) _Pragma("unroll") for (int k = 0; k < 2; ++k) dst[m][k] = *(const PG8_LAS bf16x8*)(lds + PG8_SA(b, h) + aoff + m * 2048 + k * 1024); } while (0)
#define PG8_LDB(dst, b, h) do { _Pragma("unroll") for (int n = 0; n < 2; ++n) _Pragma("unroll") for (int k = 0; k < 2; ++k) dst[n][k] = *(const PG8_LAS bf16x8*)(lds + PG8_SB(b, h) + boff + n * 2048 + k * 1024); } while (0)
#define PG8_MMA(ai, bj, At, Bt) do { __builtin_amdgcn_s_setprio(1); _Pragma("unroll") for (int m = 0; m < 4; ++m) _Pragma("unroll") for (int n = 0; n < 2; ++n) _Pragma("unroll") for (int k = 0; k < 2; ++k) \
        acc[ai][bj][m][n] = __builtin_amdgcn_mfma_f32_16x16x32_bf16(Bt[n][k], At[m][k], acc[ai][bj][m][n], 0, 0, 0); __builtin_amdgcn_s_setprio(0); } while (0)
#define PG8_WAIT_V(n) asm volatile("s_waitcnt vmcnt(" #n ")" ::: "memory")
#define PG8_WAIT_L(n) asm volatile("s_waitcnt lgkmcnt(" #n ")" ::: "memory")
#define PG8_BAR __builtin_amdgcn_s_barrier()
#define PG8_SCHED __builtin_amdgcn_sched_barrier(0)
    Unit cur, nxt; int ui = 0;
    if (!S.next(0, cur)) return;
    f32x4 acc[2][2][4][2];
#pragma unroll
    for (int a = 0; a < 2; ++a)
#pragma unroll
        for (int b = 0; b < 2; ++b)
#pragma unroll
            for (int m = 0; m < 4; ++m)
#pragma unroll
                for (int n = 0; n < 2; ++n) acc[a][b][m][n] = (f32x4){0.f, 0.f, 0.f, 0.f};
    bf16x8 At[4][2], B0[2][2], B1[2][2];
    const char* cA = (const char*)g.A + (size_t)cur.pm * tstep; const char* cB = (const char*)g.Bt + (size_t)cur.pn * tstep;
    S.a_ready(cur);
    if constexpr (SP2) {
        PG8_STAGE(PG8_SB(0, 0), cB, voffB); PG8_STAGE(PG8_SB(0, 1), cB + hstep, voffB); PG8_STAGE(PG8_SA(0, 0), cA, voffA); PG8_STAGE(PG8_SA(0, 1), cA + hstep, voffA);
        if (wr == 1) PG8_BAR;
        PG8_WAIT_V(2); PG8_BAR;
        PG8_STAGE(PG8_SB(1, 0), cB + kstep, voffB); PG8_STAGE(PG8_SA(1, 0), cA + kstep, voffA); PG8_STAGE(PG8_SB(1, 1), cB + hstep + kstep, voffB);
        PG8_WAIT_V(6); PG8_BAR;
    } else {
        PG8_STAGE(PG8_SB(0, 0), cB, voffB); PG8_STAGE(PG8_SA(0, 0), cA, voffA); PG8_STAGE(PG8_SB(0, 1), cB + hstep, voffB); PG8_STAGE(PG8_SA(0, 1), cA + hstep, voffA);
        if (wr == 1) PG8_BAR;
        PG8_WAIT_V(4); PG8_BAR;
        PG8_STAGE(PG8_SB(1, 0), cB + kstep, voffB); PG8_STAGE(PG8_SA(1, 0), cA + kstep, voffA); PG8_STAGE(PG8_SB(1, 1), cB + hstep + kstep, voffB);
        PG8_WAIT_V(6); PG8_BAR;
    }
    for (;;) {
        const bool has_next = S.next(ui + 1, nxt);
        const char* nA = has_next ? (const char*)g.A + (size_t)nxt.pm * tstep : cA; const char* nB = has_next ? (const char*)g.Bt + (size_t)nxt.pn * tstep : cB;
        for (int t = 0; t < nt; t += 2) {
            const bool last = (t == nt - 2);
            const char* a1 = cA + (size_t)(t + 1) * kstep;
            const char* a2 = last ? nA : cA + (size_t)(t + 2) * kstep; const char* b2 = last ? nB : cB + (size_t)(t + 2) * kstep;
            const char* a3 = a2 + kstep; const char* b3 = b2 + kstep;
            if (last && has_next) S.a_ready(nxt);
            if constexpr (SP2) {
            PG8_LDB(B0, 0, 0); PG8_LDB(B1, 0, 1); PG8_SCHED; PG8_LDA(At, 0, 0); PG8_STAGE(PG8_SA(1, 1), a1 + hstep, voffA);
            PG8_WAIT_V(8); PG8_WAIT_L(0); PG8_BAR; PG8_MMA(0, 0, At, B0); PG8_MMA(0, 1, At, B1); PG8_BAR; PG8_SCHED;
            PG8_LDA(At, 0, 1); PG8_STAGE(PG8_SB(0, 0), b2, voffB); PG8_STAGE(PG8_SB(0, 1), b2 + hstep, voffB); PG8_STAGE(PG8_SA(0, 0), a2, voffA);
            PG8_WAIT_V(8); PG8_WAIT_L(0); PG8_BAR; PG8_MMA(1, 0, At, B0); PG8_MMA(1, 1, At, B1); PG8_BAR; PG8_SCHED;
            PG8_LDB(B0, 1, 0); PG8_LDB(B1, 1, 1); PG8_SCHED; PG8_LDA(At, 1, 0); PG8_STAGE(PG8_SA(0, 1), a2 + hstep, voffA);
            PG8_WAIT_V(8); PG8_WAIT_L(0); PG8_BAR; PG8_MMA(0, 0, At, B0); PG8_MMA(0, 1, At, B1); PG8_BAR; PG8_SCHED;
            PG8_LDA(At, 1, 1); PG8_STAGE(PG8_SB(1, 0), b3, voffB); PG8_STAGE(PG8_SB(1, 1), b3 + hstep, voffB); PG8_STAGE(PG8_SA(1, 0), a3, voffA);
            PG8_WAIT_V(8); PG8_WAIT_L(0); PG8_BAR; PG8_MMA(1, 0, At, B0); PG8_MMA(1, 1, At, B1); PG8_BAR; PG8_SCHED;
            } else {
            PG8_LDB(B0, 0, 0); PG8_SCHED; PG8_LDA(At, 0, 0); PG8_STAGE(PG8_SA(1, 1), a1 + hstep, voffA);
            PG8_WAIT_L(8); PG8_BAR; PG8_WAIT_L(0); PG8_MMA(0, 0, At, B0); PG8_BAR; PG8_SCHED;
            PG8_LDB(B1, 0, 1); PG8_STAGE(PG8_SB(0, 0), b2, voffB);
            PG8_BAR; PG8_WAIT_L(0); PG8_MMA(0, 1, At, B1); PG8_BAR;
            PG8_LDA(At, 0, 1); PG8_STAGE(PG8_SA(0, 0), a2, voffA);
            PG8_BAR; PG8_WAIT_L(0); PG8_MMA(1, 0, At, B0); PG8_BAR; PG8_SCHED;
            PG8_STAGE(PG8_SB(0, 1), b2 + hstep, voffB);
            PG8_WAIT_V(6); PG8_BAR; PG8_MMA(1, 1, At, B1); PG8_BAR;
            PG8_LDB(B0, 1, 0); PG8_SCHED; PG8_LDA(At, 1, 0); PG8_STAGE(PG8_SA(0, 1), a2 + hstep, voffA);
            PG8_WAIT_L(8); PG8_BAR; PG8_WAIT_L(0); PG8_MMA(0, 0, At, B0); PG8_BAR; PG8_SCHED;
            PG8_LDB(B1, 1, 1); PG8_STAGE(PG8_SB(1, 0), b3, voffB);
            PG8_BAR; PG8_WAIT_L(0); PG8_MMA(0, 1, At, B1); PG8_BAR;
            PG8_LDA(At, 1, 1); PG8_STAGE(PG8_SA(1, 0), a3, voffA);
            PG8_BAR; PG8_WAIT_L(0); PG8_MMA(1, 0, At, B0); PG8_BAR; PG8_SCHED;
            PG8_STAGE(PG8_SB(1, 1), b3 + hstep, voffB);
            PG8_WAIT_V(6); PG8_BAR; PG8_MMA(1, 1, At, B1); PG8_BAR;
            }
        }
        if constexpr (ALIGN_EPI) { if (wr == 0) PG8_BAR; }
        if constexpr (!Epi::AFTER_DRAIN) { E(acc, cur, wr, wc, fr, fq); S.done(cur); }
        if (!has_next) break;
#pragma unroll
        for (int a = 0; a < 2; ++a)
#pragma unroll
            for (int b = 0; b < 2; ++b)
#pragma unroll
                for (int m = 0; m < 4; ++m)
#pragma unroll
                    for (int n = 0; n < 2; ++n) acc[a][b][m][n] = (f32x4){0.f, 0.f, 0.f, 0.f};
        cur = nxt; cA = nA; cB = nB; ++ui;
        if constexpr (ALIGN_EPI) { if (wr == 1) PG8_BAR; }
    }
    PG8_WAIT_V(0);
    if constexpr (!ALIGN_EPI) { if (wr == 0) PG8_BAR; }
    PG8_BAR;
    if constexpr (Epi::AFTER_DRAIN) { E.fused(acc, cur, wr, wc, fr, fq, lds, wid, lane); S.done(cur); }
#undef PG8_SA
#undef PG8_SB
#undef PG8_STAGE
#undef PG8_LDA
#undef PG8_LDB
#undef PG8_MMA
#undef PG8_WAIT_V
#undef PG8_WAIT_L
#undef PG8_BAR
#undef PG8_SCHED
}
}
#define XB_TMO      128
#define XB_XCNT(j)  (256  + 64 * (j))
#define XB_XSUB(j)  (1280 + 64 * (j))
#define XB_XGEN(j)  (2304 + 64 * (j))
#define XB_TOP      3328
#define XB_TOPGEN   3392
#define XCD_BAR_WORDS 3456
#define XB_SPIN_CAP (1u << 18)

__device__ __forceinline__ unsigned xb_ld(unsigned* p)              { return __hip_atomic_load(p, __ATOMIC_RELAXED, __HIP_MEMORY_SCOPE_AGENT); }
__device__ __forceinline__ unsigned xb_add(unsigned* p, unsigned v) { return __hip_atomic_fetch_add(p, v, __ATOMIC_RELAXED, __HIP_MEMORY_SCOPE_AGENT); }
__device__ __forceinline__ unsigned xb_xcc_id() { return (unsigned)__builtin_amdgcn_s_getreg((3 << 11) | 20) & 0xFu; }
#define XB_SPIN(cond, bar) do { unsigned _sp = 0; while (cond) { __builtin_amdgcn_s_sleep(1); \
    if ((++_sp & 255u) == 0u) { if (xb_ld(&(bar)[XB_TMO])) break; if (_sp > XB_SPIN_CAP) { atomicAdd(&(bar)[XB_TMO], 1u); break; } } } } while (0)

struct XcdBarrier {
    unsigned* bar; unsigned x;
    volatile LAS unsigned* st;
};

__device__ __forceinline__ XcdBarrier xcd_barrier_post(unsigned* bar, volatile LAS unsigned* st) {
    XcdBarrier b; b.bar = bar; b.x = xb_xcc_id(); b.st = st;
    if (threadIdx.x == 0) (void)xb_add(&bar[XB_XCNT(b.x)], 1u);
    return b;
}
__device__ __forceinline__ void xcd_barrier_complete(unsigned* bar, unsigned x, unsigned& nloc, unsigned& nx) {
    const unsigned G = gridDim.x * gridDim.y * gridDim.z;
    unsigned sum, cnt, mine, sp = 0u;
    for (;;) {
        sum = 0u; cnt = 0u; mine = 0u;
#pragma unroll
        for (unsigned j = 0; j < 16; ++j) { const unsigned c = xb_ld(&bar[XB_XCNT(j)]); sum += c; cnt += (c > 0u) ? 1u : 0u; mine = (j == x) ? c : mine; }
        if (sum == G) break;
        __builtin_amdgcn_s_sleep(1);
        if ((++sp & 255u) == 0u) { if (xb_ld(&bar[XB_TMO])) break; if (sp > XB_SPIN_CAP) { atomicAdd(&bar[XB_TMO], 1u); break; } }
    }
    nloc = mine > 0u ? mine : 1u; nx = cnt > 0u ? cnt : 1u;
}

__device__ __forceinline__ void xcd_barrier(const XcdBarrier& b) {
    asm volatile("s_waitcnt vmcnt(0)" ::: "memory");
    __syncthreads();
    if (threadIdx.x == 0) {
        unsigned* bar = b.bar;
        __builtin_amdgcn_s_waitcnt(0);
        unsigned nloc = b.st[0], nx = b.st[1];
        if (nloc == 0u) { xcd_barrier_complete(bar, b.x, nloc, nx); b.st[0] = nloc; b.st[1] = nx; }
        const unsigned old = xb_add(&bar[XB_XSUB(b.x)], 1u);
        const unsigned gen = old / nloc;
        if (old + 1u == (gen + 1u) * nloc) {
            __builtin_amdgcn_fence(__ATOMIC_RELEASE, "agent");
            asm volatile("s_waitcnt vmcnt(0)" ::: "memory");
            const unsigned og = xb_add(&bar[XB_TOP], 1u);
            const unsigned tg = og / nx;
            if (og + 1u == (tg + 1u) * nx) xb_add(&bar[XB_TOPGEN], 1u);
            else XB_SPIN(xb_ld(&bar[XB_TOPGEN]) == tg, bar);
            __builtin_amdgcn_fence(__ATOMIC_ACQUIRE, "agent");
            xb_add(&bar[XB_XGEN(b.x)], 1u);
            asm volatile("s_waitcnt vmcnt(0)" ::: "memory");
        } else {
            XB_SPIN(xb_ld(&bar[XB_XGEN(b.x)]) == gen, bar);
            __builtin_amdgcn_fence(__ATOMIC_ACQUIRE, "agent");
            asm volatile("s_waitcnt vmcnt(0)" ::: "memory");
        }
    }
    __syncthreads();
}
struct Args { const float* in[N_IN]; float* out; unsigned char* ws; int ph_lo, ph_hi; };

#ifndef MK_CONV_ADJ
#define MK_CONV_ADJ 1
#endif
#ifndef MK_CONV_TAIL
#define MK_CONV_TAIL 16
#endif
__device__ __forceinline__ void p0_transpose_item(const float* W, int K, int N, bf16* WT, int dmode, LAS float* scr, int item, int lane) {
    const int nblk = N / 32, kb = item / nblk, nb = item % nblk, k0 = 64 * kb, n0 = 32 * nb;
#pragma unroll 8
    for (int i = 0; i < 32; ++i) { const int kk = 2 * i + (lane >> 5); scr[kk * 33 + (lane & 31)] = W[(size_t)(k0 + kk) * N + n0 + (lane & 31)]; }
    LDS_WAIT(); asm volatile("" ::: "memory");
    const int c = lane & 7;
    const int d0 = dmode == 0 ? n0 : ((n0 >> 7) * 256 + (n0 & 127) + (dmode == 2 ? 128 : 0));
#pragma unroll
    for (int j = 0; j < 4; ++j) { const int n = (lane >> 3) + 8 * j; const LAS float* s = scr + (8 * c) * 33 + n;
        v4u o; o.x = pk2(s[0 * 33], s[1 * 33]); o.y = pk2(s[2 * 33], s[3 * 33]); o.z = pk2(s[4 * 33], s[5 * 33]); o.w = pk2(s[6 * 33], s[7 * 33]);
        *(GAS v4u*)(WT + (size_t)(d0 + n) * K + k0 + 8 * c) = o; }
    LDS_WAIT(); asm volatile("" ::: "memory");
}
#ifndef MODR
#define MODR 8
#endif
__device__ __forceinline__ void p0_mod_unit(const Args& a, int unit, LAS unsigned char* lds, int tid, int wave, int lane) {
    const int l = unit / 48, jb = unit % 48;
    LAS float* S = (LAS float*)lds;
    for (int i = tid; i < 9 * DM; i += NWAVES * 64) { const int mi = i / DM, k = i % DM; const float x = mi == 0 ? a.in[I_CCTX][k] : a.in[I_C][(mi - 1) * DM + k]; S[i] = silu_f(x); }
    __syncthreads();
    const float* W = a.in[I_MODW] + (size_t)l * DM * 12288 + jb * 256 + 4 * lane;
    f32x4 acc[9];
#pragma unroll
    for (int mi = 0; mi < 9; ++mi) acc[mi] = (f32x4){0.f, 0.f, 0.f, 0.f};
    const int kbeg = wave * 256;
    f32x4 wa[MODR], wb[MODR];
#define MOD_FMA(WS, KB) do { _Pragma("unroll") for (int i_ = 0; i_ < MODR; ++i_) { _Pragma("unroll") for (int mi = 0; mi < 9; ++mi) { const float s = S[mi * DM + (KB) + i_]; acc[mi] += WS[i_] * s; } } } while (0)
#pragma unroll
    for (int i = 0; i < MODR; ++i) wa[i] = __builtin_nontemporal_load((const f32x4*)(W + (size_t)(kbeg + i) * 12288));
#pragma unroll 1
    for (int kk = 0; kk < 256; kk += 2 * MODR) {
#pragma unroll
        for (int i = 0; i < MODR; ++i) wb[i] = __builtin_nontemporal_load((const f32x4*)(W + (size_t)(kbeg + kk + MODR + i) * 12288));
        MOD_FMA(wa, kbeg + kk);
        if (kk + 2 * MODR < 256) {
#pragma unroll
            for (int i = 0; i < MODR; ++i) wa[i] = __builtin_nontemporal_load((const f32x4*)(W + (size_t)(kbeg + kk + 2 * MODR + i) * 12288)); }
        MOD_FMA(wb, kbeg + kk + MODR);
    }
#undef MOD_FMA
    __syncthreads();
    LAS float* R = (LAS float*)lds;
#pragma unroll
    for (int mi = 0; mi < 9; ++mi) *(LAS f32x4*)(R + (wave * 9 + mi) * 256 + 4 * lane) = acc[mi];
    __syncthreads();
    float* MOD = (float*)(a.ws + WS_MOD);
    for (int i = tid; i < 9 * 256; i += NWAVES * 64) { const int mi = i >> 8, c = i & 255; float s = 0.f;
#pragma unroll
        for (int w = 0; w < 8; ++w) s += R[(w * 9 + mi) * 256 + c];
        const int j = jb * 256 + c; MOD[((size_t)l * 9 + mi) * 12288 + j] = s + a.in[I_MODB][l * 12288 + j]; }
    __syncthreads();
}
struct ConvItem { const float* src; bf16* dst; int N, K; };
__device__ __forceinline__ ConvItem p0_conv_decode(const Args& a, int l, int it) {
    constexpr int I_IN = (DM / 64) * (INW / 32), I_OUT = (DM / 64) * (DM / 32), I_G = (DM / 64) * (DFF / 32);
    const float* W; bf16* WT; int K, N, dmode, r = it;
    if (r < I_IN) { W = a.in[I_WIN] + (size_t)l * DM * INW; K = DM; N = INW; WT = (bf16*)(a.ws + WS_WIN) + (size_t)l * INW * DM; dmode = 0; }
    else if ((r -= I_IN) < I_OUT) { W = a.in[I_WOUT] + (size_t)l * DM * DM; K = DM; N = DM; WT = (bf16*)(a.ws + WS_WOUT) + (size_t)l * DM * DM; dmode = 0; }
    else if ((r -= I_OUT) < I_G) { W = a.in[I_WGATE] + (size_t)l * DM * DFF; K = DM; N = DFF; WT = (bf16*)(a.ws + WS_WGU) + (size_t)l * NGU * DM; dmode = 1; }
    else if ((r -= I_G) < I_G) { W = a.in[I_WUP] + (size_t)l * DM * DFF; K = DM; N = DFF; WT = (bf16*)(a.ws + WS_WGU) + (size_t)l * NGU * DM; dmode = 2; }
    else { r -= I_G; W = a.in[I_WDOWN] + (size_t)l * DFF * DM; K = DFF; N = DM; WT = (bf16*)(a.ws + WS_WDN) + (size_t)l * DM * DFF; dmode = 0; }
    const int nblk = N / 32, kb = r / nblk, nb = r % nblk, k0 = 64 * kb, n0 = 32 * nb;
    const int d0 = dmode == 0 ? n0 : ((n0 >> 7) * 256 + (n0 & 127) + (dmode == 2 ? 128 : 0));
    ConvItem c; c.src = W + (size_t)k0 * N + n0; c.dst = WT + (size_t)d0 * K + k0; c.N = N; c.K = K; return c;
}
__device__ __forceinline__ void p0_convert_layer(const Args& a, int l, LAS unsigned char* lds, int wave, int lane, int gw0, int ngw, int sixteenths_lo, int sixteenths_hi) {
    LAS float* scr = (LAS float*)(lds + RING_OFF + wave * 16384);
    constexpr int PER_L = (DM / 64) * (INW / 32) + (DM / 64) * (DM / 32) + 2 * (DM / 64) * (DFF / 32) + (DFF / 64) * (DM / 32);
    const int it_lo = PER_L / 16 * sixteenths_lo, it_hi = sixteenths_hi >= 16 ? PER_L : PER_L / 16 * sixteenths_hi, gw = it_lo + gw0;
    if (gw >= it_hi) return;
    float ld[32];
    ConvItem cur = p0_conv_decode(a, l, gw);
    { const float* s = cur.src + (size_t)(lane >> 5) * cur.N + (lane & 31);
#pragma unroll
      for (int i = 0; i < 32; ++i) ld[i] = __builtin_nontemporal_load(s + (size_t)(2 * i) * cur.N);     }
    for (int it = gw;; it += ngw) {
#pragma unroll
        for (int i = 0; i < 32; ++i) scr[(2 * i + (lane >> 5)) * 33 + (lane & 31)] = ld[i];
        LDS_WAIT(); asm volatile("" ::: "memory");
        const bool more = it + ngw < it_hi; ConvItem nxt = cur;
        if (more) { nxt = p0_conv_decode(a, l, it + ngw); const float* s = nxt.src + (size_t)(lane >> 5) * nxt.N + (lane & 31);
#pragma unroll
            for (int i = 0; i < 32; ++i) ld[i] = __builtin_nontemporal_load(s + (size_t)(2 * i) * nxt.N); }
        const int c = lane & 7;
#pragma unroll
        for (int j = 0; j < 4; ++j) { const int n = (lane >> 3) + 8 * j; const LAS float* s = scr + (8 * c) * 33 + n;
            v4u o; o.x = pk2(s[0 * 33], s[1 * 33]); o.y = pk2(s[2 * 33], s[3 * 33]); o.z = pk2(s[4 * 33], s[5 * 33]); o.w = pk2(s[6 * 33], s[7 * 33]);
            __builtin_nontemporal_store(o, (GAS v4u*)(cur.dst + (size_t)n * cur.K + 8 * c)); }
        LDS_WAIT(); asm volatile("" ::: "memory");
        if (!more) break;
        cur = nxt;
    }
}
__device__ __forceinline__ void p0_prologue(const Args& a, LAS unsigned char* lds, int tid, int wave, int lane, int G) {
    const int bid = blockIdx.x;
    for (int u = bid; u < 192; u += G) p0_mod_unit(a, u, lds, tid, wave, lane);
    { const int gt = bid * (NWAVES * 64) + tid; if (gt < 2048) { const int pos = gt >> 5, i = gt & 31; const float fr = exp2f(-(float)i * (13.287712379549449f / 32.0f)); const float ang = (float)pos * fr;
        float* R = (float*)(a.ws + WS_ROPE); R[gt * 2] = cosf(ang); R[gt * 2 + 1] = sinf(ang); } }
    { const size_t gt = (size_t)bid * (NWAVES * 64) + tid, nthr = (size_t)G * NWAVES * 64;
      const size_t n8a = 6291456 / 8, n8b = 2097152 / 8;
      for (size_t i = gt; i < 2 * n8a + 2 * n8b; i += nthr) {
          const float* src; bf16* dst; size_t j = i;
          if (j < n8a) { src = a.in[I_CAK]; dst = (bf16*)(a.ws + WS_CAK); }
          else if ((j -= n8a) < n8a) { src = a.in[I_CAV]; dst = (bf16*)(a.ws + WS_CAV); }
          else if ((j -= n8a) < n8b) { src = a.in[I_CBK]; dst = (bf16*)(a.ws + WS_CBK); }
          else { j -= n8b; src = a.in[I_CBV]; dst = (bf16*)(a.ws + WS_CBV); }
          const f32x4 x0 = __builtin_nontemporal_load((const f32x4*)(src + j * 8)), x1 = __builtin_nontemporal_load((const f32x4*)(src + j * 8 + 4));
          v4u o; o.x = pk2(x0[0], x0[1]); o.y = pk2(x0[2], x0[3]); o.z = pk2(x1[0], x1[1]); o.w = pk2(x1[2], x1[3]);
          *(v4u*)(dst + j * 8) = o; } }
    for (int l = 0; l < DEPTH; ++l) p0_convert_layer(a, l, lds, wave, lane, MK_CONV_ADJ ? bid * NWAVES + wave : wave * G + bid, G * NWAVES, l == 0 ? 0 : MK_CONV_TAIL, 16);
}

#ifndef MK_XBF16
#define MK_XBF16 1
#endif
struct ThinRow { v4u f[4]; f32x4 x[8]; v4u xb[4]; };
template <int MODE>
__device__ __forceinline__ void thin_load(ThinRow& r, const Args& a, int row, int lane, size_t f_off) {
    if (MODE == 0 || !MK_XBF16) {
        const float* xs = MODE == 0 ? (row < NCTX ? a.in[I_XP] + (size_t)row * DM : a.in[I_XS] + (size_t)(row - NCTX) * DM) : a.out + (size_t)row * DM;
#pragma unroll
        for (int j = 0; j < 4; ++j) { if (MODE == 0) { r.x[2 * j] = __builtin_nontemporal_load((const f32x4*)(xs + 8 * lane + 512 * j)); r.x[2 * j + 1] = __builtin_nontemporal_load((const f32x4*)(xs + 8 * lane + 512 * j + 4)); }
            else { r.x[2 * j] = *(const f32x4*)(xs + 8 * lane + 512 * j); r.x[2 * j + 1] = *(const f32x4*)(xs + 8 * lane + 512 * j + 4); } }
    } else { const bf16* xs = (const bf16*)(a.ws + WS_XB) + (size_t)row * DM;
#pragma unroll
        for (int j = 0; j < 4; ++j) r.xb[j] = *(const v4u*)(xs + 8 * lane + 512 * j); }
    if (MODE == 1) { const bf16* fs = (const bf16*)(a.ws + f_off) + (size_t)row * DM;
#pragma unroll
        for (int j = 0; j < 4; ++j) r.f[j] = __builtin_nontemporal_load((const v4u*)(fs + 8 * lane + 512 * j)); }
}
__device__ __forceinline__ void unpack8f(const v4u w, f32x4& a, f32x4& b) { a = (f32x4){bflo(w.x), bfhi(w.x), bflo(w.y), bfhi(w.y)}; b = (f32x4){bflo(w.z), bfhi(w.z), bflo(w.w), bfhi(w.w)}; }
template <int MODE, bool HAS_H>
__device__ __forceinline__ void thin_phase(const Args& a, LAS unsigned char* lds, int tid, int wave, int lane, int G, const float* gpost, int gate_sel, int lgate, const float* gpre, int scale_sel, int shift_sel, int lnext) {
    const size_t f_off = gate_sel == 5 ? WS_F2 : WS_F1;
    float* X = a.out; bf16* XB = (bf16*)(a.ws + WS_XB); bf16* H = (bf16*)(a.ws + WS_H); const float* MOD = (const float*)(a.ws + WS_MOD);
    constexpr bool XOUT_BF = MK_XBF16 && HAS_H;
    LAS float* VG = (LAS float*)lds; LAS float* VW = VG + DM; LAS float* VS = VW + DM;
    for (int chunk = blockIdx.x; chunk < MROWS / 64; chunk += G) {
        const int r0 = chunk * 64, mi = r0 < NCTX ? 0 : 1 + ((r0 - NCTX) >> 10);
        { const int c = 4 * tid;
          if (MODE == 1) { const f32x4 gt = *(const f32x4*)(MOD + ((size_t)lgate * 9 + mi) * 12288 + gate_sel * DM + c), gp = *(const f32x4*)(gpost + c); *(LAS f32x4*)(VG + c) = gt * gp; }
          if (HAS_H) { const f32x4 gp = *(const f32x4*)(gpre + c), s1 = *(const f32x4*)(MOD + ((size_t)lnext * 9 + mi) * 12288 + scale_sel * DM + c), s0 = *(const f32x4*)(MOD + ((size_t)lnext * 9 + mi) * 12288 + shift_sel * DM + c);
              *(LAS f32x4*)(VW + c) = gp * (s1 + 1.0f); *(LAS f32x4*)(VS + c) = s0; } }
        ThinRow cur, nxt;
        const int rw = r0 + wave * 8;
        thin_load<MODE>(cur, a, rw, lane, f_off);
        __syncthreads();
        for (int k = 0; k < 8; ++k) {
            const int row = rw + k;
            if (k + 1 < 8) thin_load<MODE>(nxt, a, row + 1, lane, f_off);
            f32x4 x[8];
            if (MODE == 0) {
#pragma unroll
                for (int j = 0; j < 8; ++j) x[j] = cur.x[j];
            } else {
                f32x4 f[8], xo[8]; float ss = 0.f;
#pragma unroll
                for (int j = 0; j < 4; ++j) { unpack8f(cur.f[j], f[2 * j], f[2 * j + 1]); if (MK_XBF16) unpack8f(cur.xb[j], xo[2 * j], xo[2 * j + 1]); else { xo[2 * j] = cur.x[2 * j]; xo[2 * j + 1] = cur.x[2 * j + 1]; } }
#pragma unroll
                for (int j = 0; j < 8; ++j) ss += (f[j][0] * f[j][0] + f[j][1] * f[j][1]) + (f[j][2] * f[j][2] + f[j][3] * f[j][3]);
                const float rstd = rsqrtf(wave_sum(ss) * (1.0f / DM) + NORM_EPS);
#pragma unroll
                for (int j = 0; j < 8; ++j) { const int c = 8 * lane + 512 * (j >> 1) + 4 * (j & 1); const f32x4 gg = *(const LAS f32x4*)(VG + c); x[j] = xo[j] + gg * (f[j] * rstd); }
            }
            if (XOUT_BF) {
#pragma unroll
                for (int j = 0; j < 4; ++j) { v4u o; o.x = pk2(x[2 * j][0], x[2 * j][1]); o.y = pk2(x[2 * j][2], x[2 * j][3]); o.z = pk2(x[2 * j + 1][0], x[2 * j + 1][1]); o.w = pk2(x[2 * j + 1][2], x[2 * j + 1][3]);
                    *(v4u*)(XB + (size_t)row * DM + 8 * lane + 512 * j) = o; }
            } else {
#pragma unroll
                for (int j = 0; j < 8; ++j) { if (MK_XBF16) __builtin_nontemporal_store(x[j], (f32x4*)(X + (size_t)row * DM + 8 * lane + 512 * (j >> 1) + 4 * (j & 1))); else *(f32x4*)(X + (size_t)row * DM + 8 * lane + 512 * (j >> 1) + 4 * (j & 1)) = x[j]; }
            }
            if (HAS_H) {
                float ss = 0.f;
#pragma unroll
                for (int j = 0; j < 8; ++j) ss += (x[j][0] * x[j][0] + x[j][1] * x[j][1]) + (x[j][2] * x[j][2] + x[j][3] * x[j][3]);
                const float rstd = rsqrtf(wave_sum(ss) * (1.0f / DM) + NORM_EPS);
#pragma unroll
                for (int j = 0; j < 4; ++j) { const int c = 8 * lane + 512 * j; f32x4 h[2];
#pragma unroll
                    for (int kk = 0; kk < 2; ++kk) { const f32x4 w = *(const LAS f32x4*)(VW + c + 4 * kk), s0 = *(const LAS f32x4*)(VS + c + 4 * kk); h[kk] = (x[2 * j + kk] * rstd) * w + s0; }
                    v4u o; o.x = pk2(h[0][0], h[0][1]); o.y = pk2(h[0][2], h[0][3]); o.z = pk2(h[1][0], h[1][1]); o.w = pk2(h[1][2], h[1][3]); *(v4u*)(H + (size_t)row * DM + c) = o; }
            }
            if (k + 1 < 8) cur = nxt;
        }
        __syncthreads();
    }
}

namespace att {
typedef short s16x4 __attribute__((ext_vector_type(4)));
typedef float f32x16 __attribute__((ext_vector_type(16)));
constexpr int SHM = 16384;
constexpr int L_V = 0, L_K = 2 * SHM, L_WS = 4 * SHM, L_TBL = L_WS + 2048, L_END = L_TBL + (64 + 480 + 64) * 4;
constexpr int OST_PITCH = 272, L_OST = 73728, OST_WAVE = 32 * OST_PITCH;
static_assert(L_END <= L_OST && L_OST + 8 * OST_WAVE <= LDSCTL_OFF, "attention LDS");
#define KSWZ(row, colB) ((row) * 256 + ((colB) ^ (((row) & 7) << 4)))
#define SBAR() __builtin_amdgcn_sched_barrier(0)
__device__ __forceinline__ int v_st(int k, int c) { const int kk = (k & ~0xC) | ((k & 4) << 1) | ((k & 8) >> 1); return ((kk >> 3) * 4 + (c >> 5)) * 512 + ((kk & 7) * 32 + (c & 31)) * 2; }
__device__ __forceinline__ int v_rd_base(int lane) { return ((lane & 3) << 3) | (((lane >> 2) & 3) << 6) | (((lane >> 4) & 1) << 5) | (((lane >> 5) & 1) << 8); }
constexpr int v_rd_off(int d0, int ks, int half) { return d0 * 512 + ks * 4096 + half * 2048; }
__device__ __forceinline__ int crow(int r, int hi) { return (r & 3) + 8 * (r >> 2) + 4 * hi; }
__device__ __forceinline__ unsigned cvtpk(float lo, float hi) { unsigned r; asm volatile("v_cvt_pk_bf16_f32 %0, %1, %2" : "=v"(r) : "v"(lo), "v"(hi)); return r; }
__device__ __forceinline__ void rope_pair(bf16x8& a, bf16x8& b, const float* rp) {
    const v4u wa = __builtin_bit_cast(v4u, a), wb = __builtin_bit_cast(v4u, b);
    const float x1[8] = {bflo(wa.x), bfhi(wa.x), bflo(wa.y), bfhi(wa.y), bflo(wa.z), bfhi(wa.z), bflo(wa.w), bfhi(wa.w)};
    const float x2[8] = {bflo(wb.x), bfhi(wb.x), bflo(wb.y), bfhi(wb.y), bflo(wb.z), bfhi(wb.z), bflo(wb.w), bfhi(wb.w)};
    const f32x4 c0 = *(const f32x4*)rp, c1 = *(const f32x4*)(rp + 4), c2 = *(const f32x4*)(rp + 8), c3 = *(const f32x4*)(rp + 12);
    const float cs[16] = {c0[0], c0[1], c0[2], c0[3], c1[0], c1[1], c1[2], c1[3], c2[0], c2[1], c2[2], c2[3], c3[0], c3[1], c3[2], c3[3]};
    float y1[8], y2[8];
#pragma unroll
    for (int e = 0; e < 8; ++e) { const float c = cs[2 * e], s = cs[2 * e + 1]; y1[e] = x1[e] * c - x2[e] * s; y2[e] = x1[e] * s + x2[e] * c; }
    v4u oa, ob; oa.x = cvtpk(y1[0], y1[1]); oa.y = cvtpk(y1[2], y1[3]); oa.z = cvtpk(y1[4], y1[5]); oa.w = cvtpk(y1[6], y1[7]);
    ob.x = cvtpk(y2[0], y2[1]); ob.y = cvtpk(y2[2], y2[3]); ob.z = cvtpk(y2[4], y2[5]); ob.w = cvtpk(y2[6], y2[7]);
    a = __builtin_bit_cast(bf16x8, oa); b = __builtin_bit_cast(bf16x8, ob);
}
__device__ __forceinline__ void qkt(f32x16& p0, f32x16& p1, const LAS unsigned char* Kt, int kq0, int kq1, int kq2, int kq3, const bf16x8* qr) {
    p0 = f32x16{}; p1 = f32x16{};
    const LAS unsigned char* kb[4] = {Kt + kq0, Kt + kq1, Kt + kq2, Kt + kq3};
#pragma unroll
    for (int d0 = 0; d0 < 8; ++d0) { const LAS unsigned char* ap = kb[d0 & 3] + (d0 >> 2) * 128;
        const bf16x8 b0 = *(const LAS bf16x8*)ap;
        const bf16x8 b1 = *(const LAS bf16x8*)(ap + 32 * 256);
        p0 = __builtin_amdgcn_mfma_f32_32x32x16_bf16(b0, qr[d0], p0, 0, 0, 0);
        p1 = __builtin_amdgcn_mfma_f32_32x32x16_bf16(b1, qr[d0], p1, 0, 0, 0); }
}
__device__ __forceinline__ void pv_tile(f32x16* o, int vb0, bf16x8 pa0, bf16x8 pa1, bf16x8 pa2, bf16x8 pa3) {
#define TRRD(dst, off) asm volatile("ds_read_b64_tr_b16 %0, %1 offset:%2" : "=&v"(dst) : "v"(vb0), "i"(off) : "memory")
#define PV_RD(S, d0) do { constexpr int b_ = v_rd_off(d0, 0, 0); TRRD(S##l0, b_); TRRD(S##h0, b_ + 2048); TRRD(S##l1, b_ + 4096); TRRD(S##h1, b_ + 6144); TRRD(S##l2, b_ + 8192); TRRD(S##h2, b_ + 10240); TRRD(S##l3, b_ + 12288); TRRD(S##h3, b_ + 14336); } while (0)
#define PV_MM(S, d0) do { \
        o[d0] = __builtin_amdgcn_mfma_f32_32x32x16_bf16(pa0, (bf16x8){S##l0[0], S##l0[1], S##l0[2], S##l0[3], S##h0[0], S##h0[1], S##h0[2], S##h0[3]}, o[d0], 0, 0, 0); \
        o[d0] = __builtin_amdgcn_mfma_f32_32x32x16_bf16(pa1, (bf16x8){S##l1[0], S##l1[1], S##l1[2], S##l1[3], S##h1[0], S##h1[1], S##h1[2], S##h1[3]}, o[d0], 0, 0, 0); \
        o[d0] = __builtin_amdgcn_mfma_f32_32x32x16_bf16(pa2, (bf16x8){S##l2[0], S##l2[1], S##l2[2], S##l2[3], S##h2[0], S##h2[1], S##h2[2], S##h2[3]}, o[d0], 0, 0, 0); \
        o[d0] = __builtin_amdgcn_mfma_f32_32x32x16_bf16(pa3, (bf16x8){S##l3[0], S##l3[1], S##l3[2], S##l3[3], S##h3[0], S##h3[1], S##h3[2], S##h3[3]}, o[d0], 0, 0, 0); } while (0)
    s16x4 Al0, Al1, Al2, Al3, Ah0, Ah1, Ah2, Ah3, Bl0, Bl1, Bl2, Bl3, Bh0, Bh1, Bh2, Bh3;
    PV_RD(A, 0); PV_RD(B, 1);
    asm volatile("s_waitcnt lgkmcnt(8)" ::: "memory"); SBAR(); PV_MM(A, 0); SBAR();
    PV_RD(A, 2);
    asm volatile("s_waitcnt lgkmcnt(8)" ::: "memory"); SBAR(); PV_MM(B, 1); SBAR();
    PV_RD(B, 3);
    asm volatile("s_waitcnt lgkmcnt(8)" ::: "memory"); SBAR(); PV_MM(A, 2); SBAR();
    asm volatile("s_waitcnt lgkmcnt(0)" ::: "memory"); SBAR(); PV_MM(B, 3);
#undef PV_MM
#undef PV_RD
#undef TRRD
}
constexpr int N_UNITS = 768, N_GMLP = 512;
#define LAUNDER(v) asm volatile("" : "+v"(v))
__device__ __forceinline__ void attn_unit(const Args& a, int l, int u, LAS unsigned char* lds, int wid, int lane_in) {
    int mode, b, head, qb = 0;
    if (u < 384) { const int v = u % 96, k = u / 96; mode = 2 + (k & 1); b = v / 12; head = (v % 12) >> 1; qb = k < 2 ? 1 + (v & 1) : ((v & 1) ? 3 : 0); }
    else if (u < 576) { const int v = u - 384; mode = 0; b = v / 6; head = v % 6; }
    else { const int v = u - 576; mode = 1; b = v / 6; head = v % 6; }
    const bool lat = mode >= 2, mixB = (mode & 1) != 0;
    const int g = head / 3;
    const int qcol = mixB ? QB_ + head * 128 : QA_ + head * 128, kcol = mixB ? KB_ + g * 128 : KA_ + head * 128, vcol = mixB ? VB_ + g * 128 : VA_ + head * 128;
    const int seq0 = lat ? NCTX + b * 1024 : b * 256, row0 = seq0 + qb * 256;
    const bf16* Z = (const bf16*)(a.ws + WS_Z); const float* rope = (const float*)(a.ws + WS_ROPE);
    const char *K1, *V1, *K2 = nullptr, *V2 = nullptr; int s1, n2 = 0, j2 = 0;
    if (!lat) { K1 = (const char*)(Z + (size_t)seq0 * INW + kcol); V1 = (const char*)(Z + (size_t)seq0 * INW + vcol); s1 = INW; }
    else {
        if (!mixB) { const size_t co = (size_t)((b * 4 + l) * 6 + head) * 256 * 128; K1 = (const char*)((const bf16*)(a.ws + WS_CAK) + co); V1 = (const char*)((const bf16*)(a.ws + WS_CAV) + co); }
        else { const size_t co = (size_t)((b * 4 + l) * 2 + g) * 256 * 128; K1 = (const char*)((const bf16*)(a.ws + WS_CBK) + co); V1 = (const char*)((const bf16*)(a.ws + WS_CBV) + co); }
        s1 = 128; K2 = (const char*)(Z + (size_t)seq0 * INW + kcol); V2 = (const char*)(Z + (size_t)seq0 * INW + vcol);
        if (!mixB) { j2 = qb <= 1 ? 0 : (qb == 2 ? 4 : 8); n2 = (qb == 0 || qb == 3) ? 8 : 11; }
        else { j2 = 4 * qb - 2 < 0 ? 0 : 4 * qb - 2; const int je = 4 * qb + 6 > 16 ? 16 : 4 * qb + 6; n2 = je - j2; }
    }
    const int NT = 4 + n2;
    LAS unsigned char* V_lds = lds + L_V; LAS unsigned char* K_lds = lds + L_K;
    LAS float* tbl = (LAS float*)(lds + L_TBL) + 64;
    bf16x8 st_k0, st_k1, st_v0, st_v1;
#define A_LOAD(t) do { const char* kp_; const char* vp_; unsigned of_; \
        if ((t) < 4) { kp_ = K1 + (size_t)(t) * 64 * s1 * 2; vp_ = V1 + (size_t)(t) * 64 * s1 * 2; of_ = of1; } \
        else { kp_ = K2 + (size_t)(j2 + (t) - 4) * 64 * INW * 2; vp_ = V2 + (size_t)(j2 + (t) - 4) * 64 * INW * 2; of_ = of2; } \
        st_k0 = *(const bf16x8*)(kp_ + of_); st_k1 = *(const bf16x8*)(kp_ + of_ + 64); st_v0 = *(const bf16x8*)(vp_ + of_); st_v1 = *(const bf16x8*)(vp_ + of_ + 64); } while (0)
    int lnu = lane_in; LAUNDER(lnu);
    const int tid_u = wid * 64 + lnu, sk_u = tid_u >> 3, cg_u = tid_u & 7, c1_u = (cg_u >> 2) * 8 + (cg_u & 3), r32 = lnu & 31, hi = lnu >> 5;
    const int kw0 = KSWZ(sk_u, c1_u * 16), kw1 = KSWZ(sk_u, (c1_u + 4) * 16), vw0 = v_st(sk_u, c1_u * 8), vw1 = v_st(sk_u, c1_u * 8 + 32);
    const unsigned of1 = (unsigned)(sk_u * s1 + c1_u * 8) * 2u, of2 = (unsigned)(sk_u * INW + c1_u * 8) * 2u;
    const int kq0 = KSWZ(r32, (0 * 16 + hi * 8) * 2), kq1 = KSWZ(r32, (1 * 16 + hi * 8) * 2), kq2 = KSWZ(r32, (2 * 16 + hi * 8) * 2), kq3 = KSWZ(r32, (3 * 16 + hi * 8) * 2);
    const int vrb = (int)(uintptr_t)V_lds + v_rd_base(lnu);
    bf16x8 qr[8];
    { const int ln = lnu;
      const char* qp = (const char*)(Z + (size_t)(row0 + wid * 32) * INW + qcol); const unsigned qo = (unsigned)(r32 * INW + hi * 8) * 2u;
#pragma unroll
      for (int d0 = 0; d0 < 8; ++d0) qr[d0] = *(const bf16x8*)(qp + qo + d0 * 32);
      A_LOAD(0);
      if (mode == 3) { const int t = qb * 256 + wid * 32 + r32; const float* rp0 = rope + ((t >> 6) * 32 + hi * 8) * 2; const float* rp1 = rope + ((t & 63) * 32 + hi * 8) * 2;
          rope_pair(qr[0], qr[2], rp0); rope_pair(qr[1], qr[3], rp0 + 32); rope_pair(qr[4], qr[6], rp1); rope_pair(qr[5], qr[7], rp1 + 32); }
      if (mode == 2) { const int tid = wid * 64 + ln; if (tid < 480) { const int ir = tid >> 5, ic = tid & 31; tbl[tid] = ic < 31 ? a.in[I_RPB][((l * 6 + head) * 15 + ir) * 31 + ic] * 11.313708498984761f : 0.f; } } }
    float m_reg = -1e30f, l_reg = 0.f;
    if (mixB) { m_reg = a.in[I_SINK][l * 6 + head] * 11.313708498984761f; l_reg = 1.f; }
    f32x16 o[4] = {};
    const int qlo = qb * 256 + wid * 32;
    const int rq = 4 * qb + (wid >> 1);
    int stA = rq - 4; stA = stA < 0 ? 0 : (stA > 8 ? 8 : stA);
    constexpr float C2 = 1.4426950408889634f * ATT_SCALE;
    for (int t = 0; t < NT; ++t) {
        const int buf = t & 1;
        const bool local = lat && t >= 4; const int j = j2 + t - 4;
        { if (local && mixB) { const float* rp = rope + (((cg_u >> 2) ? sk_u : j) * 32 + (cg_u & 3) * 8) * 2; rope_pair(st_k0, st_k1, rp); }
          *(LAS bf16x8*)(K_lds + buf * SHM + kw0) = st_k0; *(LAS bf16x8*)(K_lds + buf * SHM + kw1) = st_k1;
          *(LAS bf16x8*)(V_lds + buf * SHM + vw0) = st_v0; *(LAS bf16x8*)(V_lds + buf * SHM + vw1) = st_v1; }
        if (t + 1 < NT) A_LOAD(t + 1);
        __syncthreads();
        bool act = true;
        if (local) { if (!mixB) act = (j >= stA) && (j < stA + 8); else act = (64 * j <= qlo + 31 + 128) && (64 * j + 63 >= qlo - 128); }
        if (act) {
            LAS float* al_l = (LAS float*)(lds + L_WS) + wid * 64 + 32;
            f32x16 p0, p1;
            qkt(p0, p1, K_lds + buf * SHM, kq0, kq1, kq2, kq3, qr);
            if (local) {
                const float NEG = -__builtin_inff();
                if (!mixB) {
                    const int cq = 32 * (wid & 1) + r32; int c0 = cq - 8; c0 = c0 < 0 ? 0 : (c0 > 48 ? 48 : c0);
                    const volatile LAS float* trow = tbl + (j - rq + 7) * 32 + (15 - cq) + 4 * hi; const int kb = 4 * hi - c0;
                    float bv[16];
#pragma unroll
                    for (int r = 0; r < 16; ++r) bv[r] = trow[(r & 3) + 8 * (r >> 2)];
#pragma unroll
                    for (int r = 0; r < 16; ++r) { const int kc = (r & 3) + 8 * (r >> 2); p0[r] = ((unsigned)(kc + kb) < 16u) ? p0[r] + bv[r] : NEG; }
#pragma unroll
                    for (int r = 0; r < 16; ++r) bv[r] = trow[(r & 3) + 8 * (r >> 2) + 32];
#pragma unroll
                    for (int r = 0; r < 16; ++r) { const int kc = (r & 3) + 8 * (r >> 2); p1[r] = ((unsigned)(kc + 32 + kb) < 16u) ? p1[r] + bv[r] : NEG; }
                } else {
                    const int dq = 64 * j + 4 * hi - (qlo + r32) + 128;
#pragma unroll
                    for (int r = 0; r < 16; ++r) { const int kc = (r & 3) + 8 * (r >> 2);
                        p0[r] = ((unsigned)(dq + kc) > 256u) ? NEG : p0[r];
                        p1[r] = ((unsigned)(dq + kc + 32) > 256u) ? NEG : p1[r]; }
                }
            }
            float pmax = p0[0];
#pragma unroll
            for (int r = 1; r < 16; ++r) pmax = fmaxf(pmax, p0[r]);
#pragma unroll
            for (int r = 0; r < 16; ++r) pmax = fmaxf(pmax, p1[r]);
            { auto rr = __builtin_amdgcn_permlane32_swap(__float_as_uint(pmax), __float_as_uint(pmax), false, false); pmax = fmaxf(__uint_as_float(rr[0]), __uint_as_float(rr[1])); }
            float mn = m_reg, alpha = 1.f;
            if (!__all((pmax - m_reg) * ATT_SCALE <= 8.0f)) { mn = fmaxf(m_reg, pmax); alpha = __builtin_amdgcn_exp2f((m_reg - mn) * C2); m_reg = mn; }
            const float mnL = -mn * C2;
            float ps = 0.f;
#pragma unroll
            for (int r = 0; r < 16; ++r) { p0[r] = __builtin_amdgcn_exp2f(fmaf(p0[r], C2, mnL)); p1[r] = __builtin_amdgcn_exp2f(fmaf(p1[r], C2, mnL)); ps += p0[r] + p1[r]; }
            { auto rr = __builtin_amdgcn_permlane32_swap(__float_as_uint(ps), __float_as_uint(ps), false, false); ps = __uint_as_float(rr[0]) + __uint_as_float(rr[1]); }
            l_reg = l_reg * alpha + ps;
            if (__any(alpha < 1.f)) { if (hi == 0) al_l[r32] = alpha; asm volatile("s_waitcnt lgkmcnt(0)" ::: "memory");
#pragma unroll
                for (int r = 0; r < 16; ++r) { const float av = al_l[crow(r, hi)];
#pragma unroll
                    for (int d_ = 0; d_ < 4; ++d_) o[d_][r] *= av; } }
            bf16x8 pa0, pa1, pa2, pa3;
#define PK4(P, B_, OUT) do { unsigned a0 = cvtpk(P[B_ + 0], P[B_ + 1]), a1 = cvtpk(P[B_ + 2], P[B_ + 3]); unsigned b0 = cvtpk(P[B_ + 4], P[B_ + 5]), b1 = cvtpk(P[B_ + 6], P[B_ + 7]); \
        auto r0 = __builtin_amdgcn_permlane32_swap(a0, b0, false, false); auto r1 = __builtin_amdgcn_permlane32_swap(a1, b1, false, false); \
        v4u w = {r0[0], r1[0], r0[1], r1[1]}; OUT = __builtin_bit_cast(bf16x8, w); } while (0)
            PK4(p0, 0, pa0); PK4(p0, 8, pa1); PK4(p1, 0, pa2); PK4(p1, 8, pa3);
#undef PK4
            pv_tile(o, vrb + buf * SHM, pa0, pa1, pa2, pa3);
        }
    }
#undef A_LOAD
    { int ln = lane_in; LAUNDER(ln); const int r32 = ln & 31, hi = ln >> 5;
      LAS float* li_l = (LAS float*)(lds + L_WS) + wid * 64;
      if (hi == 0) li_l[r32] = l_reg; asm volatile("s_waitcnt lgkmcnt(0)" ::: "memory");
      LAS unsigned char* ost = lds + L_OST + wid * OST_WAVE;
#pragma unroll
      for (int r = 0; r < 16; ++r) { const int orow0 = (r & 3) + 8 * (r >> 2); const float rl = __builtin_amdgcn_rcpf(li_l[orow0 + 4 * hi]);
#pragma unroll
          for (int d0 = 0; d0 < 4; ++d0) *(LAS unsigned short*)(ost + (orow0 + 4 * hi) * OST_PITCH + (d0 * 32 + r32) * 2) = (unsigned short)f2bf(o[d0][r] * rl); }
      asm volatile("s_waitcnt lgkmcnt(0)" ::: "memory");
      char* Ow = (char*)((bf16*)(a.ws + WS_MRG) + (size_t)(row0 + wid * 32) * DM + (mixB ? 768 : 0) + head * 128);
#pragma unroll
      for (int i = 0; i < 8; ++i) { const int row = (ln >> 4) + 4 * i; const v4u w = *(const LAS v4u*)(ost + row * OST_PITCH + (ln & 15) * 16);
          *(v4u*)(Ow + (size_t)row * DM * 2 + (ln & 15) * 16) = w; } }
    __syncthreads();
}
#undef LAUNDER
#undef KSWZ
#undef SBAR

constexpr int GT_PITCH = 136;
__device__ __forceinline__ void gmlp_unit(const Args& a, int l, int unit, LAS unsigned char* lds, int tid, int wave, int lane) {
    const int n = unit >> 2, g = unit & 3, R0 = n * 128;
    const bf16* Z = (const bf16*)(a.ws + WS_Z); bf16* MR = (bf16*)(a.ws + WS_MRG);
    LAS unsigned short* T = (LAS unsigned short*)lds;
    LAS float* ST = (LAS float*)(lds + 128 * GT_PITCH * 2);
    const int fi = lane & 15, kg = lane >> 4, p = wave * 16 + fi;
    bf16x8 wf[4];
    { const float* W = a.in[I_GW] + (size_t)((l * 4 + g) * 128 + p) * 128 + 8 * kg;
#pragma unroll
      for (int ks = 0; ks < 4; ++ks) { const f32x4 x0 = *(const f32x4*)(W + 32 * ks), x1 = *(const f32x4*)(W + 32 * ks + 4);
          v4u w; w.x = att::cvtpk(x0[0], x0[1]); w.y = att::cvtpk(x0[2], x0[3]); w.z = att::cvtpk(x1[0], x1[1]); w.w = att::cvtpk(x1[2], x1[3]); wf[ks] = __builtin_bit_cast(bf16x8, w); } }
    { const int q = tid >> 2, cp = tid & 3; const bf16* zp = Z + (size_t)(R0 + q) * INW + VC_ + cp * 8; v4u vw[16];
#pragma unroll
      for (int i = 0; i < 16; ++i) vw[i] = *(const v4u*)(zp + i * 32);
      float s = 0.f, s2 = 0.f;
#pragma unroll
      for (int i = 0; i < 16; ++i) { const v4u w = vw[i]; const float v[8] = {bflo(w.x), bfhi(w.x), bflo(w.y), bfhi(w.y), bflo(w.z), bfhi(w.z), bflo(w.w), bfhi(w.w)};
#pragma unroll
          for (int e = 0; e < 8; ++e) { s += v[e]; s2 += v[e] * v[e]; } }
      s += __shfl_xor(s, 1); s2 += __shfl_xor(s2, 1); s += __shfl_xor(s, 2); s2 += __shfl_xor(s2, 2);
      const float mean = s * (1.0f / 512.0f), var = s2 * (1.0f / 512.0f) - mean * mean;
      if (cp == 0) { ST[q * 2] = mean; ST[q * 2 + 1] = rsqrtf(var + NORM_EPS); } }
    __syncthreads();
    { const int q = tid >> 2, cp = tid & 3; const float mean = ST[q * 2], rstd = ST[q * 2 + 1];
      const bf16* zp = Z + (size_t)(R0 + q) * INW + VC_ + g * 128 + cp * 32; const float* lg = a.in[I_LNG] + l * 512 + g * 128 + cp * 32; const float* lb = a.in[I_LNB] + l * 512 + g * 128 + cp * 32;
#pragma unroll
      for (int c8 = 0; c8 < 4; ++c8) { const v4u w = *(const v4u*)(zp + c8 * 8);
          const float v[8] = {bflo(w.x), bfhi(w.x), bflo(w.y), bfhi(w.y), bflo(w.z), bfhi(w.z), bflo(w.w), bfhi(w.w)};
#pragma unroll
          for (int e = 0; e < 8; ++e) { const int c = cp * 32 + c8 * 8 + e; const float y = (v[e] - mean) * rstd * lg[c8 * 8 + e] + lb[c8 * 8 + e]; T[c * GT_PITCH + q] = (unsigned short)f2bf(y); } } }
    __syncthreads();
    f32x4 acc[8];
#pragma unroll
    for (int cb = 0; cb < 8; ++cb) acc[cb] = (f32x4){0.f, 0.f, 0.f, 0.f};
#pragma unroll
    for (int cb = 0; cb < 8; ++cb)
#pragma unroll
        for (int ks = 0; ks < 4; ++ks) { const bf16x8 af = *(const LAS bf16x8*)(T + (cb * 16 + fi) * GT_PITCH + 32 * ks + 8 * kg);
            acc[cb] = __builtin_amdgcn_mfma_f32_16x16x32_bf16(af, wf[ks], acc[cb], 0, 0, 0); }
    const float bs = a.in[I_GB][(l * 4 + g) * 128 + p];
#pragma unroll
    for (int cb = 0; cb < 8; ++cb) { const int ch = g * 128 + cb * 16 + 4 * kg; const v2u uw = *(const v2u*)(Z + (size_t)(R0 + p) * INW + UC_ + ch);
        v2u ow; ow.x = att::cvtpk(bflo(uw.x) * (acc[cb][0] + bs), bfhi(uw.x) * (acc[cb][1] + bs)); ow.y = att::cvtpk(bflo(uw.y) * (acc[cb][2] + bs), bfhi(uw.y) * (acc[cb][3] + bs));
        *(v2u*)(MR + (size_t)(R0 + p) * DM + 1536 + ch) = ow; }
    __syncthreads();
}
}
constexpr int N_PHASES = 2 + 7 * DEPTH;
#ifndef MK_SP2
#define MK_SP2 true
#endif
#ifndef MK_ALIGN
#define MK_ALIGN true
#endif
#ifndef MK_REP_T0
#define MK_REP_T0 1
#endif
#ifndef MK_REP_P0
#define MK_REP_P0 1
#endif
#ifndef MK_REP_G1
#define MK_REP_G1 1
#endif
#ifndef MK_REP_MIX
#define MK_REP_MIX 1
#endif
#ifndef MK_REP_G2
#define MK_REP_G2 1
#endif
#ifndef MK_REP_G3
#define MK_REP_G3 1
#endif
#ifndef MK_REP_G4
#define MK_REP_G4 1
#endif
__global__ void __launch_bounds__(NWAVES * 64, 2) fwd_kernel(Args args) {
    extern __shared__ __attribute__((aligned(16))) unsigned char lds_raw[];
    LAS unsigned char* lds = (LAS unsigned char*)lds_raw;
    volatile LAS unsigned* MISC = (volatile LAS unsigned*)(lds + MISC_OFF);
    const int tid = threadIdx.x, G = gridDim.x; const int wave_s = __builtin_amdgcn_readfirstlane(tid >> 6);
    unsigned* ctl = (unsigned*)(args.ws + WS_CTL);
    for (int u = tid; u < (LDS_BYTES - LDSCTL_OFF) / 4; u += NWAVES * 64) ((LAS unsigned*)(lds + LDSCTL_OFF))[u] = 0u;
    __syncthreads();
    XcdBarrier bar = xcd_barrier_post(ctl + CW_BAR, MISC + 8);
    const int lo = args.ph_lo, hi = args.ph_hi;
#define IN(k) (lo <= (k) && (k) < hi)
#define PHASE_IDS() int lane_p = (int)__builtin_amdgcn_mbcnt_hi(~0u, __builtin_amdgcn_mbcnt_lo(~0u, 0u)); asm volatile("" : "+v"(lane_p)); const int wave_p = wave_s, tid_p = wave_s * 64 + lane_p; (void)tid_p; (void)wave_p
#ifndef MK_WGM_G2
#define MK_WGM_G2 4
#endif
#ifndef MK_WGM_G4
#define MK_WGM_G4 4
#endif
#ifndef MK_WS_TOP
#define MK_WS_TOP 1
#endif
#ifndef MK_REP_SEAM
#define MK_REP_SEAM 0
#endif
#ifndef MK_REP_BAR
#define MK_REP_BAR 1
#endif
#define SEAM(k) do { if ((k) + 1 < hi) { for (int rb_ = 0; rb_ < MK_REP_BAR; ++rb_) xcd_barrier(bar); } } while (0)

    if (IN(0)) { for (int rep = 0; rep < MK_REP_P0; ++rep) { PHASE_IDS(); p0_prologue(args, lds, tid_p, wave_p, lane_p, G); __syncthreads(); } SEAM(0); }
    if (IN(1)) { for (int rep = 0; rep < MK_REP_T0; ++rep) { PHASE_IDS(); thin_phase<0, true>(args, lds, tid_p, wave_p, lane_p, G, nullptr, 0, 0, args.in[I_NMPRE], 1, 0, 0); } SEAM(1); }

    for (int l = 0; l < DEPTH; ++l) {
        const int pb = 2 + 7 * l;
        if (IN(pb + 0)) {
            pg8::Gemm g{(const pg8::bf16_t*)(args.ws + WS_H), (const pg8::bf16_t*)(args.ws + WS_WIN) + (size_t)l * INW * DM, MROWS, INW, DM};
            pg8::StaticOrder S; S.init(MROWS, INW, G, (int)blockIdx.x);
            pg8::EpiWin E{(pg8::bf16_t*)(args.ws + WS_Z), args.out, l};
            for (int rep = 0; rep < MK_REP_G1; ++rep)
            pg8::gemm_phase<pg8::EpiWin, pg8::StaticOrder, MK_ALIGN, MK_SP2>(lds + RING_OFF, g, S, E, wave_s);
            if (MK_CONV_TAIL && l + 1 < DEPTH) { constexpr int total = (MROWS / 256) * (INW / 256); const int rounds = (total + G - 1) / G, nshort = rounds * G - total, c = (int)blockIdx.x;
                if (nshort == 0) { PHASE_IDS(); p0_convert_layer(args, l + 1, lds, wave_p, lane_p, MK_CONV_ADJ ? c * NWAVES + wave_p : wave_p * G + c, G * NWAVES, 0, MK_CONV_TAIL); }
                else if (c >= G - nshort) { PHASE_IDS(); p0_convert_layer(args, l + 1, lds, wave_p, lane_p, MK_CONV_ADJ ? (c - (G - nshort)) * NWAVES + wave_p : wave_p * nshort + (c - (G - nshort)), nshort * NWAVES, 0, MK_CONV_TAIL); } }
            SEAM(pb + 0);
        }
        if (IN(pb + 1)) {
            PHASE_IDS();
            for (int rep = 0; rep < MK_REP_MIX; ++rep) {
                unsigned* qctr = ctl + CW_QUEUE + 64 * (l + 4 * rep); volatile LAS unsigned* qw = MISC + 16;
                unsigned tk = 0;
                if (tid_p == 0) qw[0] = __hip_atomic_fetch_add(qctr, 1u, __ATOMIC_RELAXED, __HIP_MEMORY_SCOPE_AGENT);
                __syncthreads(); tk = (unsigned)__builtin_amdgcn_readfirstlane((int)qw[0]); __syncthreads();
                while (tk < (unsigned)att::N_UNITS) {
                    unsigned nx = 0; if (tid_p == 0) nx = __hip_atomic_fetch_add(qctr, 1u, __ATOMIC_RELAXED, __HIP_MEMORY_SCOPE_AGENT);
                    att::attn_unit(args, l, (int)tk, lds + RING_OFF, wave_p, lane_p);
                    if (tid_p == 0) qw[0] = nx;
                    __syncthreads(); tk = (unsigned)__builtin_amdgcn_readfirstlane((int)qw[0]); __syncthreads();
                }
                while (tk < (unsigned)(att::N_UNITS + att::N_GMLP)) {
                    unsigned nx = 0; if (tid_p == 0) nx = __hip_atomic_fetch_add(qctr, 1u, __ATOMIC_RELAXED, __HIP_MEMORY_SCOPE_AGENT);
                    att::gmlp_unit(args, l, (int)tk - att::N_UNITS, lds + RING_OFF, tid_p, wave_p, lane_p);
                    if (tid_p == 0) qw[0] = nx;
                    __syncthreads(); tk = (unsigned)__builtin_amdgcn_readfirstlane((int)qw[0]); __syncthreads();
                }
            }
            SEAM(pb + 1);
        }
        if (IN(pb + 2)) {
            pg8::Gemm g{(const pg8::bf16_t*)(args.ws + WS_MRG), (const pg8::bf16_t*)(args.ws + WS_WOUT) + (size_t)l * DM * DM, MROWS, DM, DM};
            pg8::StaticOrder S; S.init(MROWS, DM, G, (int)blockIdx.x, MK_WGM_G2);
            pg8::EpiBf16 E{(pg8::bf16_t*)(args.ws + WS_F1), DM};
            for (int rep = 0; rep < MK_REP_G2; ++rep) {
            pg8::gemm_phase<pg8::EpiBf16, pg8::StaticOrder, MK_ALIGN, MK_SP2>(lds + RING_OFF, g, S, E, wave_s);
            if (MK_REP_SEAM && rep + 1 < MK_REP_G2) xcd_barrier(bar); }
            SEAM(pb + 2);
        }
        if (IN(pb + 3)) {
            PHASE_IDS(); thin_phase<1, true>(args, lds, tid_p, wave_p, lane_p, G, args.in[I_NMPOST] + l * DM, 2, l, args.in[I_NFPRE] + l * DM, 4, 3, l);
            SEAM(pb + 3);
        }
        if (IN(pb + 4)) {
            pg8::Gemm g{(const pg8::bf16_t*)(args.ws + WS_H), (const pg8::bf16_t*)(args.ws + WS_WGU) + (size_t)l * NGU * DM, MROWS, NGU, DM};
            pg8::StaticOrder S; S.init(MROWS, NGU, G, (int)blockIdx.x);
            pg8::EpiGU E{(pg8::bf16_t*)(args.ws + WS_ACT)};
            for (int rep = 0; rep < MK_REP_G3; ++rep)
            pg8::gemm_phase<pg8::EpiGU, pg8::StaticOrder, MK_ALIGN, MK_SP2>(lds + RING_OFF, g, S, E, wave_s);
            SEAM(pb + 4);
        }
        if (IN(pb + 5)) {
            pg8::Gemm g{(const pg8::bf16_t*)(args.ws + WS_ACT), (const pg8::bf16_t*)(args.ws + WS_WDN) + (size_t)l * DM * DFF, MROWS, DM, DFF};
            pg8::StaticOrder S; S.init(MROWS, DM, G, (int)blockIdx.x, MK_WGM_G4);
            pg8::EpiBf16 E{(pg8::bf16_t*)(args.ws + WS_F2), DM};
            for (int rep = 0; rep < MK_REP_G4; ++rep)
            pg8::gemm_phase<pg8::EpiBf16, pg8::StaticOrder, MK_ALIGN, MK_SP2>(lds + RING_OFF, g, S, E, wave_s);
            SEAM(pb + 5);
        }
        if (IN(pb + 6)) {
            PHASE_IDS();
            if (l + 1 < DEPTH) thin_phase<1, true>(args, lds, tid_p, wave_p, lane_p, G, args.in[I_NFPOST] + l * DM, 5, l, args.in[I_NMPRE] + (l + 1) * DM, 1, 0, l + 1);
            else thin_phase<1, false>(args, lds, tid_p, wave_p, lane_p, G, args.in[I_NFPOST] + l * DM, 5, l, nullptr, 0, 0, 0);
            SEAM(pb + 6);
        }
    }
#undef IN
#undef SEAM
}

#ifndef MK_LAUNCH_MODE
#define MK_LAUNCH_MODE 0
#endif
extern "C" void kernel_launch(void* const* d_in, const int* in_sizes, int n_in, void* d_out, int out_size, void* d_ws, size_t ws_size, hipStream_t stream) {
    static int grid = 0;
    if (grid == 0) {
        if (n_in != N_IN || (size_t)out_size != O_END || ws_size < WS_END) { fprintf(stderr, "kernel_launch: unexpected shapes: n_in %d out %d ws %zu\n", n_in, out_size, ws_size); grid = -1; return; }
        int dev = 0, cus = 0, per_cu = 0;
        if (hipGetDevice(&dev) != hipSuccess || hipDeviceGetAttribute(&cus, hipDeviceAttributeMultiprocessorCount, dev) != hipSuccess) { fprintf(stderr, "kernel_launch: device query failed\n"); grid = -1; return; }
        if (hipFuncSetAttribute((const void*)fwd_kernel, hipFuncAttributeMaxDynamicSharedMemorySize, LDS_BYTES) != hipSuccess) { fprintf(stderr, "kernel_launch: hipFuncSetAttribute failed\n"); grid = -1; return; }
        if (hipOccupancyMaxActiveBlocksPerMultiprocessor(&per_cu, (const void*)fwd_kernel, NWAVES * 64, LDS_BYTES) != hipSuccess || per_cu < 1)
            fprintf(stderr, "kernel_launch: note: occupancy query reports %d workgroups per CU\n", per_cu);
        (void)hipGetLastError();
        grid = cus;
    }
    if (grid < 0) return;
    const size_t ws_shift = MK_WS_TOP ? ((ws_size - WS_END) & ~(size_t)(2 * MiB - 1)) : 0;
    if (hipMemsetAsync((char*)d_ws + ws_shift + WS_CTL, 0, CTL_ZERO_BYTES, stream) != hipSuccess) { fprintf(stderr, "kernel_launch: memset failed\n"); return; }
    Args a{};
    for (int i = 0; i < N_IN; ++i) a.in[i] = (const float*)d_in[i];
    a.out = (float*)d_out; a.ws = (unsigned char*)d_ws + ws_shift;
#if MK_LAUNCH_MODE == 1
    a.ph_lo = 0; a.ph_hi = N_PHASES;
    hipLaunchKernelGGL(fwd_kernel, dim3(grid), dim3(NWAVES * 64), LDS_BYTES, stream, a);
#else
    for (int p = 0; p < N_PHASES; ++p) { a.ph_lo = p; a.ph_hi = p + 1;
        hipLaunchKernelGGL(fwd_kernel, dim3(grid), dim3(NWAVES * 64), LDS_BYTES, stream, a); }
#endif
    const hipError_t le = hipPeekAtLastError();
    if (le != hipSuccess) fprintf(stderr, "kernel_launch: launch failed: %s\n", hipGetErrorName(le));
}
```

```cpp
#include <hip/hip_runtime.h>
#include <cstdio>
#include <cstdint>
#define MK_LAUNCH_MODE 1
constexpr int DM = 2048, DEPTH = 4, NCTX = 8192, MROWS = 16384, INW = 4608, DFF = 5632, NGU = 11264;
constexpr int QA_ = 0, KA_ = 768, VA_ = 1536, QB_ = 2304, KB_ = 3072, VB_ = 3328, UC_ = 3584, VC_ = 4096;
constexpr float ATT_SCALE = 0.08838834764831845f;
constexpr float NORM_EPS = 1e-6f;
constexpr int NWAVES = 8;
enum { I_XP = 0, I_XS, I_CAK, I_CAV, I_CBK, I_CBV, I_C, I_CCTX, I_MODW, I_MODB, I_NMPRE, I_NMPOST, I_NFPRE, I_NFPOST, I_WIN, I_WOUT, I_RPB, I_SINK, I_LNG, I_LNB, I_GW, I_GB, I_WGATE, I_WUP, I_WDOWN, N_IN };
constexpr size_t O_Y = 0, O_AK = 33554432ull, O_AV = 58720256ull, O_BK = 83886080ull, O_BV = 92274688ull, O_END = 100663296ull;
constexpr size_t MiB = 1u << 20;
constexpr size_t WS_CTL = 0, CTL_ZERO_BYTES = 1 * MiB;
constexpr size_t WS_MOD = 1 * MiB;
constexpr size_t WS_ROPE = 3 * MiB;
constexpr size_t WS_CAK = 4 * MiB, WS_CAV = 16 * MiB, WS_CBK = 28 * MiB, WS_CBV = 32 * MiB;
constexpr size_t WS_WIN = 40 * MiB;
constexpr size_t WS_WOUT = 112 * MiB;
constexpr size_t WS_WGU = 144 * MiB;
constexpr size_t WS_WDN = 320 * MiB;
constexpr size_t WS_A = 408 * MiB, WS_B = 472 * MiB;
constexpr size_t WS_H = WS_A;
constexpr size_t WS_Z = WS_B;
constexpr size_t WS_MRG = WS_A;
constexpr size_t WS_F1 = WS_B;
constexpr size_t WS_F2 = WS_A;
constexpr size_t WS_ACT = WS_B;
constexpr size_t WS_XB = 648 * MiB;
constexpr size_t WS_END = 712 * MiB;
constexpr int CW_BAR = 4096;
constexpr int CW_QUEUE = 16384;
constexpr int RING_OFF = 0, RING_BYTES = 131072;
constexpr int LDSCTL_OFF = 143360, MISC_OFF = LDSCTL_OFF + 320;
constexpr int LDS_BYTES = 147456;
static_assert(MISC_OFF + 128 <= LDS_BYTES, "LDS map");

#define GAS __attribute__((address_space(1)))
#define LAS __attribute__((address_space(3)))
typedef unsigned short bf16;
typedef unsigned v4u __attribute__((ext_vector_type(4)));
typedef unsigned v2u __attribute__((ext_vector_type(2)));
typedef float f32x4 __attribute__((ext_vector_type(4)));
typedef short bf16x8 __attribute__((ext_vector_type(8)));
typedef GAS unsigned gu32;
#define RLX_AGENT __ATOMIC_RELAXED, __HIP_MEMORY_SCOPE_AGENT
#define LDS_WAIT() asm volatile("s_waitcnt lgkmcnt(0)" ::: "memory")
#define VM_WAIT() asm volatile("s_waitcnt vmcnt(0)" ::: "memory")
__device__ __forceinline__ unsigned f2bf(float f) { unsigned u = __builtin_bit_cast(unsigned, f); return (u + 0x7fffu + ((u >> 16) & 1u)) >> 16; }
__device__ __forceinline__ unsigned pk2(float lo, float hi) { return f2bf(lo) | (f2bf(hi) << 16); }
__device__ __forceinline__ float bf2f(unsigned short b) { return __uint_as_float(((unsigned)b) << 16); }
__device__ __forceinline__ float bflo(unsigned w) { return __uint_as_float(w << 16); }
__device__ __forceinline__ float bfhi(unsigned w) { return __uint_as_float(w & 0xffff0000u); }
__device__ __forceinline__ float wave_sum(float v) {
#pragma unroll
    for (int o = 1; o < 64; o <<= 1) v += __shfl_xor(v, o);
    return v;
}
__device__ __forceinline__ float wave_max(float v) {
#pragma unroll
    for (int o = 1; o < 64; o <<= 1) v = fmaxf(v, __shfl_xor(v, o));
    return v;
}
__device__ __forceinline__ float fast_sigmoid(float y) { return __builtin_amdgcn_rcpf(1.0f + __builtin_amdgcn_exp2f(-1.4426950408889634f * y)); }
__device__ __forceinline__ float gelu_tanh(float x) { const float y = 0.7978845608028654f * (x + 0.044715f * x * x * x); return x * fast_sigmoid(2.0f * y); }
__device__ __forceinline__ float silu_f(float x) { return x * fast_sigmoid(x); }
#ifndef MK_WGM
#define MK_WGM 8
#endif
namespace pg8 {
#define PG8_LAS __attribute__((address_space(3)))
typedef unsigned short bf16_t;
typedef short bf16x8 __attribute__((ext_vector_type(8)));
typedef float f32x4 __attribute__((ext_vector_type(4)));
typedef unsigned u32x4 __attribute__((ext_vector_type(4)));
constexpr int BM = 256, BK = 64, HALF = 128, HTB = HALF * BK * 2  , STAGE_BYTES = 8 * HTB, NXCD = 8, WGM = MK_WGM;

__host__ __device__ __forceinline__ int lds_byte(int r, int c) { const int st = (r >> 4) * 2 + (c >> 5), rr = r & 15, cc = c & 31, ob = rr * 64 + cc * 2; return st * 1024 + (ob ^ (((ob >> 9) & 1) << 5)); }
__host__ __device__ __forceinline__ void stage_rc(int b, int& R, int& C) { const int st = b / 1024, sb = b % 1024, swz = sb ^ (((sb >> 9) & 1) << 5); R = (st >> 1) * 16 + swz / 64; C = (st & 1) * 32 + (swz % 64) / 2; }
__host__ __device__ __forceinline__ int perm32(int rho) { const int n = rho >> 4, i = rho & 15; return 8 * (i >> 2) + 4 * n + (i & 3); }

struct Unit { int pm, pn; };
struct Gemm { const bf16_t* A; const bf16_t* Bt; int M, N, K; };

struct StaticOrder {
    int nM, nN, nwg, G, c, wgm;
    __host__ __device__ void init(int M, int N, int G_, int c_, int wgm_ = WGM) { nM = M / BM; nN = N / BM; nwg = nM * nN; G = G_; c = c_; wgm = wgm_; }
    __host__ __device__ bool next(int i, Unit& u) const {
        const long L = (long)i * G + c; if (L >= nwg) return false;
        int wgid = (int)L; { const int q = nwg / NXCD, r = nwg % NXCD, xcd = wgid % NXCD, off = wgid / NXCD; wgid = (xcd < r ? xcd * (q + 1) : r * (q + 1) + (xcd - r) * q) + off; }
        const int nig = wgm * nN, gid = wgid / nig, fm = gid * wgm, gsz = (nM - fm) < wgm ? (nM - fm) : wgm;
        u.pm = fm + ((wgid % nig) % gsz); u.pn = (wgid % nig) / gsz; return true;
    }
    __device__ __forceinline__ void a_ready(const Unit&) const {}
    __device__ __forceinline__ void done(const Unit&) const {}
};
__device__ __forceinline__ unsigned cvt_pk_bf16(float lo, float hi) { unsigned r; asm volatile("v_cvt_pk_bf16_f32 %0, %1, %2" : "=v"(r) : "v"(lo), "v"(hi)); return r; }
typedef float f32x2 __attribute__((ext_vector_type(2)));

struct EpiF32 {
    static constexpr bool PERM = false, AFTER_DRAIN = false;
    float* C; int ldc;
    __device__ __forceinline__ void operator()(const f32x4 (&acc)[2][2][4][2], const Unit& u, int wr, int wc, int fr, int fq) const {
        const int row0 = u.pm * BM + wr * 64 + fr, col0 = u.pn * BM + wc * 32 + 4 * fq;
#pragma unroll
        for (int ai = 0; ai < 2; ++ai)
#pragma unroll
            for (int m = 0; m < 4; ++m) { float* rowp = C + (size_t)(row0 + ai * HALF + m * 16) * ldc + col0;
#pragma unroll
                for (int bj = 0; bj < 2; ++bj)
#pragma unroll
                    for (int n = 0; n < 2; ++n) *(f32x4*)(rowp + bj * HALF + n * 16) = acc[ai][bj][m][n]; }
    }
};
struct EpiWin {
    static constexpr bool PERM = true, AFTER_DRAIN = false;
    bf16_t* Z; float* out; int layer;
    __device__ __forceinline__ void operator()(const f32x4 (&acc)[2][2][4][2], const Unit& u, int wr, int wc, int fr, int fq) const {
        const int row0 = u.pm * BM + wr * 64 + fr, colb = u.pn * BM + wc * 32 + 8 * fq;
        const bool act = u.pn >= 14;
        bool kv = false; size_t kvbase = 0; int nh = 6, h0 = 0;
        if (u.pm < 32) {
            if (u.pn >= 3 && u.pn <= 5)      { kv = true; kvbase = 33554432ull; nh = 6; h0 = 2 * (u.pn - 3); }
            else if (u.pn >= 6 && u.pn <= 8) { kv = true; kvbase = 58720256ull; nh = 6; h0 = 2 * (u.pn - 6); }
            else if (u.pn == 12)             { kv = true; kvbase = 83886080ull; nh = 2; h0 = 0; }
            else if (u.pn == 13)             { kv = true; kvbase = 92274688ull; nh = 2; h0 = 0; }
        }
#pragma unroll
        for (int ai = 0; ai < 2; ++ai)
#pragma unroll
            for (int m = 0; m < 4; ++m) { const int row = row0 + ai * HALF + m * 16; bf16_t* rowp = Z + (size_t)row * 4608 + colb;
#pragma unroll
                for (int bj = 0; bj < 2; ++bj) { f32x4 v0 = acc[ai][bj][m][0], v1 = acc[ai][bj][m][1];
                    if (kv) { float* p = out + kvbase + ((((size_t)u.pm * 4 + layer) * nh + h0 + bj) * 256 + (row - u.pm * BM)) * 128 + wc * 32 + 8 * fq;
                        __builtin_nontemporal_store(v0, (f32x4*)p); __builtin_nontemporal_store(v1, (f32x4*)(p + 4)); }
                    if (act) {
#pragma unroll
                        for (int j = 0; j < 4; ++j) { v0[j] = gelu_tanh(v0[j]); v1[j] = gelu_tanh(v1[j]); } }
                    u32x4 w; w.x = cvt_pk_bf16(v0[0], v0[1]); w.y = cvt_pk_bf16(v0[2], v0[3]); w.z = cvt_pk_bf16(v1[0], v1[1]); w.w = cvt_pk_bf16(v1[2], v1[3]);
                    *(u32x4*)(rowp + bj * HALF) = w; } }
    }
};
struct EpiGU {
    static constexpr bool PERM = true, AFTER_DRAIN = false;
    bf16_t* O;
    __device__ __forceinline__ void operator()(const f32x4 (&acc)[2][2][4][2], const Unit& u, int wr, int wc, int fr, int fq) const {
        const int row0 = u.pm * BM + wr * 64 + fr, col0 = u.pn * HALF + wc * 32 + 8 * fq;
#pragma unroll
        for (int ai = 0; ai < 2; ++ai)
#pragma unroll
            for (int m = 0; m < 4; ++m) { bf16_t* rowp = O + (size_t)(row0 + ai * HALF + m * 16) * 5632 + col0;
                f32x4 v0, v1;
#pragma unroll
                for (int j = 0; j < 4; ++j) { v0[j] = silu_f(acc[ai][0][m][0][j]) * acc[ai][1][m][0][j]; v1[j] = silu_f(acc[ai][0][m][1][j]) * acc[ai][1][m][1][j]; }
                u32x4 w; w.x = cvt_pk_bf16(v0[0], v0[1]); w.y = cvt_pk_bf16(v0[2], v0[3]); w.z = cvt_pk_bf16(v1[0], v1[1]); w.w = cvt_pk_bf16(v1[2], v1[3]);
                *(u32x4*)rowp = w; }
    }
};

struct EpiBf16 {
    static constexpr bool PERM = true, AFTER_DRAIN = false;
    bf16_t* O; int ldc;
    __device__ __forceinline__ void operator()(const f32x4 (&acc)[2][2][4][2], const Unit& u, int wr, int wc, int fr, int fq) const {
        const int row0 = u.pm * BM + wr * 64 + fr, col0 = u.pn * BM + wc * 32 + 8 * fq;
#pragma unroll
        for (int ai = 0; ai < 2; ++ai)
#pragma unroll
            for (int m = 0; m < 4; ++m) { bf16_t* rowp = O + (size_t)(row0 + ai * HALF + m * 16) * ldc + col0;
#pragma unroll
                for (int bj = 0; bj < 2; ++bj) { const f32x4 v0 = acc[ai][bj][m][0], v1 = acc[ai][bj][m][1];
                    u32x4 w; w.x = cvt_pk_bf16(v0[0], v0[1]); w.y = cvt_pk_bf16(v0[2], v0[3]); w.z = cvt_pk_bf16(v1[0], v1[1]); w.w = cvt_pk_bf16(v1[2], v1[3]);
                    *(u32x4*)(rowp + bj * HALF) = w; } }
    }
};
template <class Epi, class Sched, bool ALIGN_EPI = false, bool SP2 = false>
__device__ __forceinline__ void gemm_phase(PG8_LAS unsigned char* lds, const Gemm g, const Sched& S, const Epi& E, const int wave_id  ) {
    int tid_l = (int)__builtin_amdgcn_mbcnt_hi(~0u, __builtin_amdgcn_mbcnt_lo(~0u, 0u)); asm volatile("" : "+v"(tid_l)); tid_l += 64 * wave_id;
    const int tid = tid_l, wid = __builtin_amdgcn_readfirstlane(tid >> 6), lane = tid & 63, wr = wid >> 2, wc = wid & 3, fr = lane & 15, fq = lane >> 4;
    const int K = g.K, nt = K / BK;
    unsigned voffA[2], voffB[2];
#pragma unroll
    for (int i = 0; i < 2; ++i) { int R, C; stage_rc(tid * 16 + i * 8192, R, C); const int Rb = Epi::PERM ? ((R & ~31) + perm32(R & 31)) : R;
        voffA[i] = (unsigned)(R * K + C) * 2u; voffB[i] = (unsigned)(Rb * K + C) * 2u; }
    const size_t kstep = (size_t)(BK * 2);
    const size_t hstep = (size_t)HALF * K * 2;
    const size_t tstep = 2 * hstep;
    const unsigned ldsw = (unsigned)wid * 1024u;
    const int aoff = lds_byte(wr * 64 + fr, fq * 8), boff = lds_byte(wc * 32 + fr, fq * 8);
#define PG8_SA(b, h) (((b) * 2 + (h)) * HTB)
#define PG8_SB(b, h) ((4 + (b) * 2 + (h)) * HTB)
#define PG8_STAGE(bufoff, gbase, voff) do { _Pragma("unroll") for (int _i = 0; _i < 2; ++_i) \
        __builtin_amdgcn_global_load_lds((const unsigned*)((const char*)(gbase) + (voff)[_i]), (PG8_LAS unsigned*)(lds + (bufoff) + ldsw + _i * 8192), 16, 0, 0); } while (0)
#define PG8_LDA(dst, b, h) do { _Pragma("unroll") for (int m = 0; m < 4; ++m) _Pragma("unroll") for (int k = 0; k < 2; ++k) dst[m][k] = *(const PG8_LAS bf16x8*)(lds + PG8_SA(b, h) + aoff + m * 2048 + k * 1024); } while (0)
#define PG8_LDB(dst, b, h) do { _Pragma("unroll") for (int n = 0; n < 2; ++n) _Pragma("unroll") for (int k = 0; k < 2; ++k) dst[n][k] = *(const PG8_LAS bf16x8*)(lds + PG8_SB(b, h) + boff + n * 2048 + k * 1024); } while (0)
#define PG8_MMA(ai, bj, At, Bt) do { __builtin_amdgcn_s_setprio(1); _Pragma("unroll") for (int m = 0; m < 4; ++m) _Pragma("unroll") for (int n = 0; n < 2; ++n) _Pragma("unroll") for (int k = 0; k < 2; ++k) \
        acc[ai][bj][m][n] = __builtin_amdgcn_mfma_f32_16x16x32_bf16(Bt[n][k], At[m][k], acc[ai][bj][m][n], 0, 0, 0); __builtin_amdgcn_s_setprio(0); } while (0)
#define PG8_WAIT_V(n) asm volatile("s_waitcnt vmcnt(" #n ")" ::: "memory")
#define PG8_WAIT_L(n) asm volatile("s_waitcnt lgkmcnt(" #n ")" ::: "memory")
#define PG8_BAR __builtin_amdgcn_s_barrier()
#define PG8_SCHED __builtin_amdgcn_sched_barrier(0)
    Unit cur, nxt; int ui = 0;
    if (!S.next(0, cur)) return;
    f32x4 acc[2][2][4][2];
#pragma unroll
    for (int a = 0; a < 2; ++a)
#pragma unroll
        for (int b = 0; b < 2; ++b)
#pragma unroll
            for (int m = 0; m < 4; ++m)
#pragma unroll
                for (int n = 0; n < 2; ++n) acc[a][b][m][n] = (f32x4){0.f, 0.f, 0.f, 0.f};
    bf16x8 At[4][2], B0[2][2], B1[2][2];
    const char* cA = (const char*)g.A + (size_t)cur.pm * tstep; const char* cB = (const char*)g.Bt + (size_t)cur.pn * tstep;
    S.a_ready(cur);
    if constexpr (SP2) {
        PG8_STAGE(PG8_SB(0, 0), cB, voffB); PG8_STAGE(PG8_SB(0, 1), cB + hstep, voffB); PG8_STAGE(PG8_SA(0, 0), cA, voffA); PG8_STAGE(PG8_SA(0, 1), cA + hstep, voffA);
        if (wr == 1) PG8_BAR;
        PG8_WAIT_V(2); PG8_BAR;
        PG8_STAGE(PG8_SB(1, 0), cB + kstep, voffB); PG8_STAGE(PG8_SA(1, 0), cA + kstep, voffA); PG8_STAGE(PG8_SB(1, 1), cB + hstep + kstep, voffB);
        PG8_WAIT_V(6); PG8_BAR;
    } else {
        PG8_STAGE(PG8_SB(0, 0), cB, voffB); PG8_STAGE(PG8_SA(0, 0), cA, voffA); PG8_STAGE(PG8_SB(0, 1), cB + hstep, voffB); PG8_STAGE(PG8_SA(0, 1), cA + hstep, voffA);
        if (wr == 1) PG8_BAR;
        PG8_WAIT_V(4); PG8_BAR;
        PG8_STAGE(PG8_SB(1, 0), cB + kstep, voffB); PG8_STAGE(PG8_SA(1, 0), cA + kstep, voffA); PG8_STAGE(PG8_SB(1, 1), cB + hstep + kstep, voffB);
        PG8_WAIT_V(6); PG8_BAR;
    }
    for (;;) {
        const bool has_next = S.next(ui + 1, nxt);
        const char* nA = has_next ? (const char*)g.A + (size_t)nxt.pm * tstep : cA; const char* nB = has_next ? (const char*)g.Bt + (size_t)nxt.pn * tstep : cB;
        for (int t = 0; t < nt; t += 2) {
            const bool last = (t == nt - 2);
            const char* a1 = cA + (size_t)(t + 1) * kstep;
            const char* a2 = last ? nA : cA + (size_t)(t + 2) * kstep; const char* b2 = last ? nB : cB + (size_t)(t + 2) * kstep;
            const char* a3 = a2 + kstep; const char* b3 = b2 + kstep;
            if (last && has_next) S.a_ready(nxt);
            if constexpr (SP2) {
            PG8_LDB(B0, 0, 0); PG8_LDB(B1, 0, 1); PG8_SCHED; PG8_LDA(At, 0, 0); PG8_STAGE(PG8_SA(1, 1), a1 + hstep, voffA);
            PG8_WAIT_V(8); PG8_WAIT_L(0); PG8_BAR; PG8_MMA(0, 0, At, B0); PG8_MMA(0, 1, At, B1); PG8_BAR; PG8_SCHED;
            PG8_LDA(At, 0, 1); PG8_STAGE(PG8_SB(0, 0), b2, voffB); PG8_STAGE(PG8_SB(0, 1), b2 + hstep, voffB); PG8_STAGE(PG8_SA(0, 0), a2, voffA);
            PG8_WAIT_V(8); PG8_WAIT_L(0); PG8_BAR; PG8_MMA(1, 0, At, B0); PG8_MMA(1, 1, At, B1); PG8_BAR; PG8_SCHED;
            PG8_LDB(B0, 1, 0); PG8_LDB(B1, 1, 1); PG8_SCHED; PG8_LDA(At, 1, 0); PG8_STAGE(PG8_SA(0, 1), a2 + hstep, voffA);
            PG8_WAIT_V(8); PG8_WAIT_L(0); PG8_BAR; PG8_MMA(0, 0, At, B0); PG8_MMA(0, 1, At, B1); PG8_BAR; PG8_SCHED;
            PG8_LDA(At, 1, 1); PG8_STAGE(PG8_SB(1, 0), b3, voffB); PG8_STAGE(PG8_SB(1, 1), b3 + hstep, voffB); PG8_STAGE(PG8_SA(1, 0), a3, voffA);
            PG8_WAIT_V(8); PG8_WAIT_L(0); PG8_BAR; PG8_MMA(1, 0, At, B0); PG8_MMA(1, 1, At, B1); PG8_BAR; PG8_SCHED;
            } else {
            PG8_LDB(B0, 0, 0); PG8_SCHED; PG8_LDA(At, 0, 0); PG8_STAGE(PG8_SA(1, 1), a1 + hstep, voffA);
            PG8_WAIT_L(8); PG8_BAR; PG8_WAIT_L(0); PG8_MMA(0, 0, At, B0); PG8_BAR; PG8_SCHED;
            PG8_LDB(B1, 0, 1); PG8_STAGE(PG8_SB(0, 0), b2, voffB);
            PG8_BAR; PG8_WAIT_L(0); PG8_MMA(0, 1, At, B1); PG8_BAR;
            PG8_LDA(At, 0, 1); PG8_STAGE(PG8_SA(0, 0), a2, voffA);
            PG8_BAR; PG8_WAIT_L(0); PG8_MMA(1, 0, At, B0); PG8_BAR; PG8_SCHED;
            PG8_STAGE(PG8_SB(0, 1), b2 + hstep, voffB);
            PG8_WAIT_V(6); PG8_BAR; PG8_MMA(1, 1, At, B1); PG8_BAR;
            PG8_LDB(B0, 1, 0); PG8_SCHED; PG8_LDA(At, 1, 0); PG8_STAGE(PG8_SA(0, 1), a2 + hstep, voffA);
            PG8_WAIT_L(8); PG8_BAR; PG8_WAIT_L(0); PG8_MMA(0, 0, At, B0); PG8_BAR; PG8_SCHED;
            PG8_LDB(B1, 1, 1); PG8_STAGE(PG8_SB(1, 0), b3, voffB);
            PG8_BAR; PG8_WAIT_L(0); PG8_MMA(0, 1, At, B1); PG8_BAR;
            PG8_LDA(At, 1, 1); PG8_STAGE(PG8_SA(1, 0), a3, voffA);
            PG8_BAR; PG8_WAIT_L(0); PG8_MMA(1, 0, At, B0); PG8_BAR; PG8_SCHED;
            PG8_STAGE(PG8_SB(1, 1), b3 + hstep, voffB);
            PG8_WAIT_V(6); PG8_BAR; PG8_MMA(1, 1, At, B1); PG8_BAR;
            }
        }
        if constexpr (ALIGN_EPI) { if (wr == 0) PG8_BAR; }
        if constexpr (!Epi::AFTER_DRAIN) { E(acc, cur, wr, wc, fr, fq); S.done(cur); }
        if (!has_next) break;
#pragma unroll
        for (int a = 0; a < 2; ++a)
#pragma unroll
            for (int b = 0; b < 2; ++b)
#pragma unroll
                for (int m = 0; m < 4; ++m)
#pragma unroll
                    for (int n = 0; n < 2; ++n) acc[a][b][m][n] = (f32x4){0.f, 0.f, 0.f, 0.f};
        cur = nxt; cA = nA; cB = nB; ++ui;
        if constexpr (ALIGN_EPI) { if (wr == 1) PG8_BAR; }
    }
    PG8_WAIT_V(0);
    if constexpr (!ALIGN_EPI) { if (wr == 0) PG8_BAR; }
    PG8_BAR;
    if constexpr (Epi::AFTER_DRAIN) { E.fused(acc, cur, wr, wc, fr, fq, lds, wid, lane); S.done(cur); }
#undef PG8_SA
#undef PG8_SB
#undef PG8_STAGE
#undef PG8_LDA
#undef PG8_LDB
#undef PG8_MMA
#undef PG8_WAIT_V
#undef PG8_WAIT_L
#undef PG8_BAR
#undef PG8_SCHED
}
}
#define XB_TMO      128
#define XB_XCNT(j)  (256  + 64 * (j))
#define XB_XSUB(j)  (1280 + 64 * (j))
#define XB_XGEN(j)  (2304 + 64 * (j))
#define XB_TOP      3328
#define XB_TOPGEN   3392
#define XCD_BAR_WORDS 3456
#define XB_SPIN_CAP (1u << 18)

__device__ __forceinline__ unsigned xb_ld(unsigned* p)              { return __hip_atomic_load(p, __ATOMIC_RELAXED, __HIP_MEMORY_SCOPE_AGENT); }
__device__ __forceinline__ unsigned xb_add(unsigned* p, unsigned v) { return __hip_atomic_fetch_add(p, v, __ATOMIC_RELAXED, __HIP_MEMORY_SCOPE_AGENT); }
__device__ __forceinline__ unsigned xb_xcc_id() { return (unsigned)__builtin_amdgcn_s_getreg((3 << 11) | 20) & 0xFu; }
#define XB_SPIN(cond, bar) do { unsigned _sp = 0; while (cond) { __builtin_amdgcn_s_sleep(1); \
    if ((++_sp & 255u) == 0u) { if (xb_ld(&(bar)[XB_TMO])) break; if (_sp > XB_SPIN_CAP) { atomicAdd(&(bar)[XB_TMO], 1u); break; } } } } while (0)

struct XcdBarrier {
    unsigned* bar; unsigned x;
    volatile LAS unsigned* st;
};

__device__ __forceinline__ XcdBarrier xcd_barrier_post(unsigned* bar, volatile LAS unsigned* st) {
    XcdBarrier b; b.bar = bar; b.x = xb_xcc_id(); b.st = st;
    if (threadIdx.x == 0) (void)xb_add(&bar[XB_XCNT(b.x)], 1u);
    return b;
}
__device__ __forceinline__ void xcd_barrier_complete(unsigned* bar, unsigned x, unsigned& nloc, unsigned& nx) {
    const unsigned G = gridDim.x * gridDim.y * gridDim.z;
    unsigned sum, cnt, mine, sp = 0u;
    for (;;) {
        sum = 0u; cnt = 0u; mine = 0u;
#pragma unroll
        for (unsigned j = 0; j < 16; ++j) { const unsigned c = xb_ld(&bar[XB_XCNT(j)]); sum += c; cnt += (c > 0u) ? 1u : 0u; mine = (j == x) ? c : mine; }
        if (sum == G) break;
        __builtin_amdgcn_s_sleep(1);
        if ((++sp & 255u) == 0u) { if (xb_ld(&bar[XB_TMO])) break; if (sp > XB_SPIN_CAP) { atomicAdd(&bar[XB_TMO], 1u); break; } }
    }
    nloc = mine > 0u ? mine : 1u; nx = cnt > 0u ? cnt : 1u;
}

__device__ __forceinline__ void xcd_barrier(const XcdBarrier& b) {
    asm volatile("s_waitcnt vmcnt(0)" ::: "memory");
    __syncthreads();
    if (threadIdx.x == 0) {
        unsigned* bar = b.bar;
        __builtin_amdgcn_s_waitcnt(0);
        unsigned nloc = b.st[0], nx = b.st[1];
        if (nloc == 0u) { xcd_barrier_complete(bar, b.x, nloc, nx); b.st[0] = nloc; b.st[1] = nx; }
        const unsigned old = xb_add(&bar[XB_XSUB(b.x)], 1u);
        const unsigned gen = old / nloc;
        if (old + 1u == (gen + 1u) * nloc) {
            __builtin_amdgcn_fence(__ATOMIC_RELEASE, "agent");
            asm volatile("s_waitcnt vmcnt(0)" ::: "memory");
            const unsigned og = xb_add(&bar[XB_TOP], 1u);
            const unsigned tg = og / nx;
            if (og + 1u == (tg + 1u) * nx) xb_add(&bar[XB_TOPGEN], 1u);
            else XB_SPIN(xb_ld(&bar[XB_TOPGEN]) == tg, bar);
            __builtin_amdgcn_fence(__ATOMIC_ACQUIRE, "agent");
            xb_add(&bar[XB_XGEN(b.x)], 1u);
            asm volatile("s_waitcnt vmcnt(0)" ::: "memory");
        } else {
            XB_SPIN(xb_ld(&bar[XB_XGEN(b.x)]) == gen, bar);
            __builtin_amdgcn_fence(__ATOMIC_ACQUIRE, "agent");
            asm volatile("s_waitcnt vmcnt(0)" ::: "memory");
        }
    }
    __syncthreads();
}
struct Args { const float* in[N_IN]; float* out; unsigned char* ws; int ph_lo, ph_hi; };

#ifndef MK_CONV_ADJ
#define MK_CONV_ADJ 1
#endif
#ifndef MK_CONV_TAIL
#define MK_CONV_TAIL 16
#endif
__device__ __forceinline__ void p0_transpose_item(const float* W, int K, int N, bf16* WT, int dmode, LAS float* scr, int item, int lane) {
    const int nblk = N / 32, kb = item / nblk, nb = item % nblk, k0 = 64 * kb, n0 = 32 * nb;
#pragma unroll 8
    for (int i = 0; i < 32; ++i) { const int kk = 2 * i + (lane >> 5); scr[kk * 33 + (lane & 31)] = W[(size_t)(k0 + kk) * N + n0 + (lane & 31)]; }
    LDS_WAIT(); asm volatile("" ::: "memory");
    const int c = lane & 7;
    const int d0 = dmode == 0 ? n0 : ((n0 >> 7) * 256 + (n0 & 127) + (dmode == 2 ? 128 : 0));
#pragma unroll
    for (int j = 0; j < 4; ++j) { const int n = (lane >> 3) + 8 * j; const LAS float* s = scr + (8 * c) * 33 + n;
        v4u o; o.x = pk2(s[0 * 33], s[1 * 33]); o.y = pk2(s[2 * 33], s[3 * 33]); o.z = pk2(s[4 * 33], s[5 * 33]); o.w = pk2(s[6 * 33], s[7 * 33]);
        *(GAS v4u*)(WT + (size_t)(d0 + n) * K + k0 + 8 * c) = o; }
    LDS_WAIT(); asm volatile("" ::: "memory");
}
#ifndef MODR
#define MODR 8
#endif
__device__ __forceinline__ void p0_mod_unit(const Args& a, int unit, LAS unsigned char* lds, int tid, int wave, int lane) {
    const int l = unit / 48, jb = unit % 48;
    LAS float* S = (LAS float*)lds;
    for (int i = tid; i < 9 * DM; i += NWAVES * 64) { const int mi = i / DM, k = i % DM; const float x = mi == 0 ? a.in[I_CCTX][k] : a.in[I_C][(mi - 1) * DM + k]; S[i] = silu_f(x); }
    __syncthreads();
    const float* W = a.in[I_MODW] + (size_t)l * DM * 12288 + jb * 256 + 4 * lane;
    f32x4 acc[9];
#pragma unroll
    for (int mi = 0; mi < 9; ++mi) acc[mi] = (f32x4){0.f, 0.f, 0.f, 0.f};
    const int kbeg = wave * 256;
    f32x4 wa[MODR], wb[MODR];
#define MOD_FMA(WS, KB) do { _Pragma("unroll") for (int i_ = 0; i_ < MODR; ++i_) { _Pragma("unroll") for (int mi = 0; mi < 9; ++mi) { const float s = S[mi * DM + (KB) + i_]; acc[mi] += WS[i_] * s; } } } while (0)
#pragma unroll
    for (int i = 0; i < MODR; ++i) wa[i] = __builtin_nontemporal_load((const f32x4*)(W + (size_t)(kbeg + i) * 12288));
#pragma unroll 1
    for (int kk = 0; kk < 256; kk += 2 * MODR) {
#pragma unroll
        for (int i = 0; i < MODR; ++i) wb[i] = __builtin_nontemporal_load((const f32x4*)(W + (size_t)(kbeg + kk + MODR + i) * 12288));
        MOD_FMA(wa, kbeg + kk);
        if (kk + 2 * MODR < 256) {
#pragma unroll
            for (int i = 0; i < MODR; ++i) wa[i] = __builtin_nontemporal_load((const f32x4*)(W + (size_t)(kbeg + kk + 2 * MODR + i) * 12288)); }
        MOD_FMA(wb, kbeg + kk + MODR);
    }
#undef MOD_FMA
    __syncthreads();
    LAS float* R = (LAS float*)lds;
#pragma unroll
    for (int mi = 0; mi < 9; ++mi) *(LAS f32x4*)(R + (wave * 9 + mi) * 256 + 4 * lane) = acc[mi];
    __syncthreads();
    float* MOD = (float*)(a.ws + WS_MOD);
    for (int i = tid; i < 9 * 256; i += NWAVES * 64) { const int mi = i >> 8, c = i & 255; float s = 0.f;
#pragma unroll
        for (int w = 0; w < 8; ++w) s += R[(w * 9 + mi) * 256 + c];
        const int j = jb * 256 + c; MOD[((size_t)l * 9 + mi) * 12288 + j] = s + a.in[I_MODB][l * 12288 + j]; }
    __syncthreads();
}
struct ConvItem { const float* src; bf16* dst; int N, K; };
__device__ __forceinline__ ConvItem p0_conv_decode(const Args& a, int l, int it) {
    constexpr int I_IN = (DM / 64) * (INW / 32), I_OUT = (DM / 64) * (DM / 32), I_G = (DM / 64) * (DFF / 32);
    const float* W; bf16* WT; int K, N, dmode, r = it;
    if (r < I_IN) { W = a.in[I_WIN] + (size_t)l * DM * INW; K = DM; N = INW; WT = (bf16*)(a.ws + WS_WIN) + (size_t)l * INW * DM; dmode = 0; }
    else if ((r -= I_IN) < I_OUT) { W = a.in[I_WOUT] + (size_t)l * DM * DM; K = DM; N = DM; WT = (bf16*)(a.ws + WS_WOUT) + (size_t)l * DM * DM; dmode = 0; }
    else if ((r -= I_OUT) < I_G) { W = a.in[I_WGATE] + (size_t)l * DM * DFF; K = DM; N = DFF; WT = (bf16*)(a.ws + WS_WGU) + (size_t)l * NGU * DM; dmode = 1; }
    else if ((r -= I_G) < I_G) { W = a.in[I_WUP] + (size_t)l * DM * DFF; K = DM; N = DFF; WT = (bf16*)(a.ws + WS_WGU) + (size_t)l * NGU * DM; dmode = 2; }
    else { r -= I_G; W = a.in[I_WDOWN] + (size_t)l * DFF * DM; K = DFF; N = DM; WT = (bf16*)(a.ws + WS_WDN) + (size_t)l * DM * DFF; dmode = 0; }
    const int nblk = N / 32, kb = r / nblk, nb = r % nblk, k0 = 64 * kb, n0 = 32 * nb;
    const int d0 = dmode == 0 ? n0 : ((n0 >> 7) * 256 + (n0 & 127) + (dmode == 2 ? 128 : 0));
    ConvItem c; c.src = W + (size_t)k0 * N + n0; c.dst = WT + (size_t)d0 * K + k0; c.N = N; c.K = K; return c;
}
__device__ __forceinline__ void p0_convert_layer(const Args& a, int l, LAS unsigned char* lds, int wave, int lane, int gw0, int ngw, int sixteenths_lo, int sixteenths_hi) {
    LAS float* scr = (LAS float*)(lds + RING_OFF + wave * 16384);
    constexpr int PER_L = (DM / 64) * (INW / 32) + (DM / 64) * (DM / 32) + 2 * (DM / 64) * (DFF / 32) + (DFF / 64) * (DM / 32);
    const int it_lo = PER_L / 16 * sixteenths_lo, it_hi = sixteenths_hi >= 16 ? PER_L : PER_L / 16 * sixteenths_hi, gw = it_lo + gw0;
    if (gw >= it_hi) return;
    float ld[32];
    ConvItem cur = p0_conv_decode(a, l, gw);
    { const float* s = cur.src + (size_t)(lane >> 5) * cur.N + (lane & 31);
#pragma unroll
      for (int i = 0; i < 32; ++i) ld[i] = __builtin_nontemporal_load(s + (size_t)(2 * i) * cur.N);     }
    for (int it = gw;; it += ngw) {
#pragma unroll
        for (int i = 0; i < 32; ++i) scr[(2 * i + (lane >> 5)) * 33 + (lane & 31)] = ld[i];
        LDS_WAIT(); asm volatile("" ::: "memory");
        const bool more = it + ngw < it_hi; ConvItem nxt = cur;
        if (more) { nxt = p0_conv_decode(a, l, it + ngw); const float* s = nxt.src + (size_t)(lane >> 5) * nxt.N + (lane & 31);
#pragma unroll
            for (int i = 0; i < 32; ++i) ld[i] = __builtin_nontemporal_load(s + (size_t)(2 * i) * nxt.N); }
        const int c = lane & 7;
#pragma unroll
        for (int j = 0; j < 4; ++j) { const int n = (lane >> 3) + 8 * j; const LAS float* s = scr + (8 * c) * 33 + n;
            v4u o; o.x = pk2(s[0 * 33], s[1 * 33]); o.y = pk2(s[2 * 33], s[3 * 33]); o.z = pk2(s[4 * 33], s[5 * 33]); o.w = pk2(s[6 * 33], s[7 * 33]);
            __builtin_nontemporal_store(o, (GAS v4u*)(cur.dst + (size_t)n * cur.K + 8 * c)); }
        LDS_WAIT(); asm volatile("" ::: "memory");
        if (!more) break;
        cur = nxt;
    }
}
__device__ __forceinline__ void p0_prologue(const Args& a, LAS unsigned char* lds, int tid, int wave, int lane, int G) {
    const int bid = blockIdx.x;
    for (int u = bid; u < 192; u += G) p0_mod_unit(a, u, lds, tid, wave, lane);
    { const int gt = bid * (NWAVES * 64) + tid; if (gt < 2048) { const int pos = gt >> 5, i = gt & 31; const float fr = exp2f(-(float)i * (13.287712379549449f / 32.0f)); const float ang = (float)pos * fr;
        float* R = (float*)(a.ws + WS_ROPE); R[gt * 2] = cosf(ang); R[gt * 2 + 1] = sinf(ang); } }
    { const size_t gt = (size_t)bid * (NWAVES * 64) + tid, nthr = (size_t)G * NWAVES * 64;
      const size_t n8a = 6291456 / 8, n8b = 2097152 / 8;
      for (size_t i = gt; i < 2 * n8a + 2 * n8b; i += nthr) {
          const float* src; bf16* dst; size_t j = i;
          if (j < n8a) { src = a.in[I_CAK]; dst = (bf16*)(a.ws + WS_CAK); }
          else if ((j -= n8a) < n8a) { src = a.in[I_CAV]; dst = (bf16*)(a.ws + WS_CAV); }
          else if ((j -= n8a) < n8b) { src = a.in[I_CBK]; dst = (bf16*)(a.ws + WS_CBK); }
          else { j -= n8b; src = a.in[I_CBV]; dst = (bf16*)(a.ws + WS_CBV); }
          const f32x4 x0 = __builtin_nontemporal_load((const f32x4*)(src + j * 8)), x1 = __builtin_nontemporal_load((const f32x4*)(src + j * 8 + 4));
          v4u o; o.x = pk2(x0[0], x0[1]); o.y = pk2(x0[2], x0[3]); o.z = pk2(x1[0], x1[1]); o.w = pk2(x1[2], x1[3]);
          *(v4u*)(dst + j * 8) = o; } }
    for (int l = 0; l < DEPTH; ++l) p0_convert_layer(a, l, lds, wave, lane, MK_CONV_ADJ ? bid * NWAVES + wave : wave * G + bid, G * NWAVES, l == 0 ? 0 : MK_CONV_TAIL, 16);
}

#ifndef MK_XBF16
#define MK_XBF16 1
#endif
struct ThinRow { v4u f[4]; f32x4 x[8]; v4u xb[4]; };
template <int MODE>
__device__ __forceinline__ void thin_load(ThinRow& r, const Args& a, int row, int lane, size_t f_off) {
    if (MODE == 0 || !MK_XBF16) {
        const float* xs = MODE == 0 ? (row < NCTX ? a.in[I_XP] + (size_t)row * DM : a.in[I_XS] + (size_t)(row - NCTX) * DM) : a.out + (size_t)row * DM;
#pragma unroll
        for (int j = 0; j < 4; ++j) { if (MODE == 0) { r.x[2 * j] = __builtin_nontemporal_load((const f32x4*)(xs + 8 * lane + 512 * j)); r.x[2 * j + 1] = __builtin_nontemporal_load((const f32x4*)(xs + 8 * lane + 512 * j + 4)); }
            else { r.x[2 * j] = *(const f32x4*)(xs + 8 * lane + 512 * j); r.x[2 * j + 1] = *(const f32x4*)(xs + 8 * lane + 512 * j + 4); } }
    } else { const bf16* xs = (const bf16*)(a.ws + WS_XB) + (size_t)row * DM;
#pragma unroll
        for (int j = 0; j < 4; ++j) r.xb[j] = *(const v4u*)(xs + 8 * lane + 512 * j); }
    if (MODE == 1) { const bf16* fs = (const bf16*)(a.ws + f_off) + (size_t)row * DM;
#pragma unroll
        for (int j = 0; j < 4; ++j) r.f[j] = __builtin_nontemporal_load((const v4u*)(fs + 8 * lane + 512 * j)); }
}
__device__ __forceinline__ void unpack8f(const v4u w, f32x4& a, f32x4& b) { a = (f32x4){bflo(w.x), bfhi(w.x), bflo(w.y), bfhi(w.y)}; b = (f32x4){bflo(w.z), bfhi(w.z), bflo(w.w), bfhi(w.w)}; }
template <int MODE, bool HAS_H>
__device__ __forceinline__ void thin_phase(const Args& a, LAS unsigned char* lds, int tid, int wave, int lane, int G, const float* gpost, int gate_sel, int lgate, const float* gpre, int scale_sel, int shift_sel, int lnext) {
    const size_t f_off = gate_sel == 5 ? WS_F2 : WS_F1;
    float* X = a.out; bf16* XB = (bf16*)(a.ws + WS_XB); bf16* H = (bf16*)(a.ws + WS_H); const float* MOD = (const float*)(a.ws + WS_MOD);
    constexpr bool XOUT_BF = MK_XBF16 && HAS_H;
    LAS float* VG = (LAS float*)lds; LAS float* VW = VG + DM; LAS float* VS = VW + DM;
    for (int chunk = blockIdx.x; chunk < MROWS / 64; chunk += G) {
        const int r0 = chunk * 64, mi = r0 < NCTX ? 0 : 1 + ((r0 - NCTX) >> 10);
        { const int c = 4 * tid;
          if (MODE == 1) { const f32x4 gt = *(const f32x4*)(MOD + ((size_t)lgate * 9 + mi) * 12288 + gate_sel * DM + c), gp = *(const f32x4*)(gpost + c); *(LAS f32x4*)(VG + c) = gt * gp; }
          if (HAS_H) { const f32x4 gp = *(const f32x4*)(gpre + c), s1 = *(const f32x4*)(MOD + ((size_t)lnext * 9 + mi) * 12288 + scale_sel * DM + c), s0 = *(const f32x4*)(MOD + ((size_t)lnext * 9 + mi) * 12288 + shift_sel * DM + c);
              *(LAS f32x4*)(VW + c) = gp * (s1 + 1.0f); *(LAS f32x4*)(VS + c) = s0; } }
        ThinRow cur, nxt;
        const int rw = r0 + wave * 8;
        thin_load<MODE>(cur, a, rw, lane, f_off);
        __syncthreads();
        for (int k = 0; k < 8; ++k) {
            const int row = rw + k;
            if (k + 1 < 8) thin_load<MODE>(nxt, a, row + 1, lane, f_off);
            f32x4 x[8];
            if (MODE == 0) {
#pragma unroll
                for (int j = 0; j < 8; ++j) x[j] = cur.x[j];
            } else {
                f32x4 f[8], xo[8]; float ss = 0.f;
#pragma unroll
                for (int j = 0; j < 4; ++j) { unpack8f(cur.f[j], f[2 * j], f[2 * j + 1]); if (MK_XBF16) unpack8f(cur.xb[j], xo[2 * j], xo[2 * j + 1]); else { xo[2 * j] = cur.x[2 * j]; xo[2 * j + 1] = cur.x[2 * j + 1]; } }
#pragma unroll
                for (int j = 0; j < 8; ++j) ss += (f[j][0] * f[j][0] + f[j][1] * f[j][1]) + (f[j][2] * f[j][2] + f[j][3] * f[j][3]);
                const float rstd = rsqrtf(wave_sum(ss) * (1.0f / DM) + NORM_EPS);
#pragma unroll
                for (int j = 0; j < 8; ++j) { const int c = 8 * lane + 512 * (j >> 1) + 4 * (j & 1); const f32x4 gg = *(const LAS f32x4*)(VG + c); x[j] = xo[j] + gg * (f[j] * rstd); }
            }
            if (XOUT_BF) {
#pragma unroll
                for (int j = 0; j < 4; ++j) { v4u o; o.x = pk2(x[2 * j][0], x[2 * j][1]); o.y = pk2(x[2 * j][2], x[2 * j][3]); o.z = pk2(x[2 * j + 1][0], x[2 * j + 1][1]); o.w = pk2(x[2 * j + 1][2], x[2 * j + 1][3]);
                    *(v4u*)(XB + (size_t)row * DM + 8 * lane + 512 * j) = o; }
            } else {
#pragma unroll
                for (int j = 0; j < 8; ++j) { if (MK_XBF16) __builtin_nontemporal_store(x[j], (f32x4*)(X + (size_t)row * DM + 8 * lane + 512 * (j >> 1) + 4 * (j & 1))); else *(f32x4*)(X + (size_t)row * DM + 8 * lane + 512 * (j >> 1) + 4 * (j & 1)) = x[j]; }
            }
            if (HAS_H) {
                float ss = 0.f;
#pragma unroll
                for (int j = 0; j < 8; ++j) ss += (x[j][0] * x[j][0] + x[j][1] * x[j][1]) + (x[j][2] * x[j][2] + x[j][3] * x[j][3]);
                const float rstd = rsqrtf(wave_sum(ss) * (1.0f / DM) + NORM_EPS);
#pragma unroll
                for (int j = 0; j < 4; ++j) { const int c = 8 * lane + 512 * j; f32x4 h[2];
#pragma unroll
                    for (int kk = 0; kk < 2; ++kk) { const f32x4 w = *(const LAS f32x4*)(VW + c + 4 * kk), s0 = *(const LAS f32x4*)(VS + c + 4 * kk); h[kk] = (x[2 * j + kk] * rstd) * w + s0; }
                    v4u o; o.x = pk2(h[0][0], h[0][1]); o.y = pk2(h[0][2], h[0][3]); o.z = pk2(h[1][0], h[1][1]); o.w = pk2(h[1][2], h[1][3]); *(v4u*)(H + (size_t)row * DM + c) = o; }
            }
            if (k + 1 < 8) cur = nxt;
        }
        __syncthreads();
    }
}

namespace att {
typedef short s16x4 __attribute__((ext_vector_type(4)));
typedef float f32x16 __attribute__((ext_vector_type(16)));
constexpr int SHM = 16384;
constexpr int L_V = 0, L_K = 2 * SHM, L_WS = 4 * SHM, L_TBL = L_WS + 2048, L_END = L_TBL + (64 + 480 + 64) * 4;
constexpr int OST_PITCH = 272, L_OST = 73728, OST_WAVE = 32 * OST_PITCH;
static_assert(L_END <= L_OST && L_OST + 8 * OST_WAVE <= LDSCTL_OFF, "attention LDS");
#define KSWZ(row, colB) ((row) * 256 + ((colB) ^ (((row) & 7) << 4)))
#define SBAR() __builtin_amdgcn_sched_barrier(0)
__device__ __forceinline__ int v_st(int k, int c) { const int kk = (k & ~0xC) | ((k & 4) << 1) | ((k & 8) >> 1); return ((kk >> 3) * 4 + (c >> 5)) * 512 + ((kk & 7) * 32 + (c & 31)) * 2; }
__device__ __forceinline__ int v_rd_base(int lane) { return ((lane & 3) << 3) | (((lane >> 2) & 3) << 6) | (((lane >> 4) & 1) << 5) | (((lane >> 5) & 1) << 8); }
constexpr int v_rd_off(int d0, int ks, int half) { return d0 * 512 + ks * 4096 + half * 2048; }
__device__ __forceinline__ int crow(int r, int hi) { return (r & 3) + 8 * (r >> 2) + 4 * hi; }
__device__ __forceinline__ unsigned cvtpk(float lo, float hi) { unsigned r; asm volatile("v_cvt_pk_bf16_f32 %0, %1, %2" : "=v"(r) : "v"(lo), "v"(hi)); return r; }
__device__ __forceinline__ void rope_pair(bf16x8& a, bf16x8& b, const float* rp) {
    const v4u wa = __builtin_bit_cast(v4u, a), wb = __builtin_bit_cast(v4u, b);
    const float x1[8] = {bflo(wa.x), bfhi(wa.x), bflo(wa.y), bfhi(wa.y), bflo(wa.z), bfhi(wa.z), bflo(wa.w), bfhi(wa.w)};
    const float x2[8] = {bflo(wb.x), bfhi(wb.x), bflo(wb.y), bfhi(wb.y), bflo(wb.z), bfhi(wb.z), bflo(wb.w), bfhi(wb.w)};
    const f32x4 c0 = *(const f32x4*)rp, c1 = *(const f32x4*)(rp + 4), c2 = *(const f32x4*)(rp + 8), c3 = *(const f32x4*)(rp + 12);
    const float cs[16] = {c0[0], c0[1], c0[2], c0[3], c1[0], c1[1], c1[2], c1[3], c2[0], c2[1], c2[2], c2[3], c3[0], c3[1], c3[2], c3[3]};
    float y1[8], y2[8];
#pragma unroll
    for (int e = 0; e < 8; ++e) { const float c = cs[2 * e], s = cs[2 * e + 1]; y1[e] = x1[e] * c - x2[e] * s; y2[e] = x1[e] * s + x2[e] * c; }
    v4u oa, ob; oa.x = cvtpk(y1[0], y1[1]); oa.y = cvtpk(y1[2], y1[3]); oa.z = cvtpk(y1[4], y1[5]); oa.w = cvtpk(y1[6], y1[7]);
    ob.x = cvtpk(y2[0], y2[1]); ob.y = cvtpk(y2[2], y2[3]); ob.z = cvtpk(y2[4], y2[5]); ob.w = cvtpk(y2[6], y2[7]);
    a = __builtin_bit_cast(bf16x8, oa); b = __builtin_bit_cast(bf16x8, ob);
}
__device__ __forceinline__ void qkt(f32x16& p0, f32x16& p1, const LAS unsigned char* Kt, int kq0, int kq1, int kq2, int kq3, const bf16x8* qr) {
    p0 = f32x16{}; p1 = f32x16{};
    const LAS unsigned char* kb[4] = {Kt + kq0, Kt + kq1, Kt + kq2, Kt + kq3};
#pragma unroll
    for (int d0 = 0; d0 < 8; ++d0) { const LAS unsigned char* ap = kb[d0 & 3] + (d0 >> 2) * 128;
        const bf16x8 b0 = *(const LAS bf16x8*)ap;
        const bf16x8 b1 = *(const LAS bf16x8*)(ap + 32 * 256);
        p0 = __builtin_amdgcn_mfma_f32_32x32x16_bf16(b0, qr[d0], p0, 0, 0, 0);
        p1 = __builtin_amdgcn_mfma_f32_32x32x16_bf16(b1, qr[d0], p1, 0, 0, 0); }
}
__device__ __forceinline__ void pv_tile(f32x16* o, int vb0, bf16x8 pa0, bf16x8 pa1, bf16x8 pa2, bf16x8 pa3) {
#define TRRD(dst, off) asm volatile("ds_read_b64_tr_b16 %0, %1 offset:%2" : "=&v"(dst) : "v"(vb0), "i"(off) : "memory")
#define PV_RD(S, d0) do { constexpr int b_ = v_rd_off(d0, 0, 0); TRRD(S##l0, b_); TRRD(S##h0, b_ + 2048); TRRD(S##l1, b_ + 4096); TRRD(S##h1, b_ + 6144); TRRD(S##l2, b_ + 8192); TRRD(S##h2, b_ + 10240); TRRD(S##l3, b_ + 12288); TRRD(S##h3, b_ + 14336); } while (0)
#define PV_MM(S, d0) do { \
        o[d0] = __builtin_amdgcn_mfma_f32_32x32x16_bf16(pa0, (bf16x8){S##l0[0], S##l0[1], S##l0[2], S##l0[3], S##h0[0], S##h0[1], S##h0[2], S##h0[3]}, o[d0], 0, 0, 0); \
        o[d0] = __builtin_amdgcn_mfma_f32_32x32x16_bf16(pa1, (bf16x8){S##l1[0], S##l1[1], S##l1[2], S##l1[3], S##h1[0], S##h1[1], S##h1[2], S##h1[3]}, o[d0], 0, 0, 0); \
        o[d0] = __builtin_amdgcn_mfma_f32_32x32x16_bf16(pa2, (bf16x8){S##l2[0], S##l2[1], S##l2[2], S##l2[3], S##h2[0], S##h2[1], S##h2[2], S##h2[3]}, o[d0], 0, 0, 0); \
        o[d0] = __builtin_amdgcn_mfma_f32_32x32x16_bf16(pa3, (bf16x8){S##l3[0], S##l3[1], S##l3[2], S##l3[3], S##h3[0], S##h3[1], S##h3[2], S##h3[3]}, o[d0], 0, 0, 0); } while (0)
    s16x4 Al0, Al1, Al2, Al3, Ah0, Ah1, Ah2, Ah3, Bl0, Bl1, Bl2, Bl3, Bh0, Bh1, Bh2, Bh3;
    PV_RD(A, 0); PV_RD(B, 1);
    asm volatile("s_waitcnt lgkmcnt(8)" ::: "memory"); SBAR(); PV_MM(A, 0); SBAR();
    PV_RD(A, 2);
    asm volatile("s_waitcnt lgkmcnt(8)" ::: "memory"); SBAR(); PV_MM(B, 1); SBAR();
    PV_RD(B, 3);
    asm volatile("s_waitcnt lgkmcnt(8)" ::: "memory"); SBAR(); PV_MM(A, 2); SBAR();
    asm volatile("s_waitcnt lgkmcnt(0)" ::: "memory"); SBAR(); PV_MM(B, 3);
#undef PV_MM
#undef PV_RD
#undef TRRD
}
constexpr int N_UNITS = 768, N_GMLP = 512;
#define LAUNDER(v) asm volatile("" : "+v"(v))
__device__ __forceinline__ void attn_unit(const Args& a, int l, int u, LAS unsigned char* lds, int wid, int lane_in) {
    int mode, b, head, qb = 0;
    if (u < 384) { const int v = u % 96, k = u / 96; mode = 2 + (k & 1); b = v / 12; head = (v % 12) >> 1; qb = k < 2 ? 1 + (v & 1) : ((v & 1) ? 3 : 0); }
    else if (u < 576) { const int v = u - 384; mode = 0; b = v / 6; head = v % 6; }
    else { const int v = u - 576; mode = 1; b = v / 6; head = v % 6; }
    const bool lat = mode >= 2, mixB = (mode & 1) != 0;
    const int g = head / 3;
    const int qcol = mixB ? QB_ + head * 128 : QA_ + head * 128, kcol = mixB ? KB_ + g * 128 : KA_ + head * 128, vcol = mixB ? VB_ + g * 128 : VA_ + head * 128;
    const int seq0 = lat ? NCTX + b * 1024 : b * 256, row0 = seq0 + qb * 256;
    const bf16* Z = (const bf16*)(a.ws + WS_Z); const float* rope = (const float*)(a.ws + WS_ROPE);
    const char *K1, *V1, *K2 = nullptr, *V2 = nullptr; int s1, n2 = 0, j2 = 0;
    if (!lat) { K1 = (const char*)(Z + (size_t)seq0 * INW + kcol); V1 = (const char*)(Z + (size_t)seq0 * INW + vcol); s1 = INW; }
    else {
        if (!mixB) { const size_t co = (size_t)((b * 4 + l) * 6 + head) * 256 * 128; K1 = (const char*)((const bf16*)(a.ws + WS_CAK) + co); V1 = (const char*)((const bf16*)(a.ws + WS_CAV) + co); }
        else { const size_t co = (size_t)((b * 4 + l) * 2 + g) * 256 * 128; K1 = (const char*)((const bf16*)(a.ws + WS_CBK) + co); V1 = (const char*)((const bf16*)(a.ws + WS_CBV) + co); }
        s1 = 128; K2 = (const char*)(Z + (size_t)seq0 * INW + kcol); V2 = (const char*)(Z + (size_t)seq0 * INW + vcol);
        if (!mixB) { j2 = qb <= 1 ? 0 : (qb == 2 ? 4 : 8); n2 = (qb == 0 || qb == 3) ? 8 : 11; }
        else { j2 = 4 * qb - 2 < 0 ? 0 : 4 * qb - 2; const int je = 4 * qb + 6 > 16 ? 16 : 4 * qb + 6; n2 = je - j2; }
    }
    const int NT = 4 + n2;
    LAS unsigned char* V_lds = lds + L_V; LAS unsigned char* K_lds = lds + L_K;
    LAS float* tbl = (LAS float*)(lds + L_TBL) + 64;
    bf16x8 st_k0, st_k1, st_v0, st_v1;
#define A_LOAD(t) do { const char* kp_; const char* vp_; unsigned of_; \
        if ((t) < 4) { kp_ = K1 + (size_t)(t) * 64 * s1 * 2; vp_ = V1 + (size_t)(t) * 64 * s1 * 2; of_ = of1; } \
        else { kp_ = K2 + (size_t)(j2 + (t) - 4) * 64 * INW * 2; vp_ = V2 + (size_t)(j2 + (t) - 4) * 64 * INW * 2; of_ = of2; } \
        st_k0 = *(const bf16x8*)(kp_ + of_); st_k1 = *(const bf16x8*)(kp_ + of_ + 64); st_v0 = *(const bf16x8*)(vp_ + of_); st_v1 = *(const bf16x8*)(vp_ + of_ + 64); } while (0)
    int lnu = lane_in; LAUNDER(lnu);
    const int tid_u = wid * 64 + lnu, sk_u = tid_u >> 3, cg_u = tid_u & 7, c1_u = (cg_u >> 2) * 8 + (cg_u & 3), r32 = lnu & 31, hi = lnu >> 5;
    const int kw0 = KSWZ(sk_u, c1_u * 16), kw1 = KSWZ(sk_u, (c1_u + 4) * 16), vw0 = v_st(sk_u, c1_u * 8), vw1 = v_st(sk_u, c1_u * 8 + 32);
    const unsigned of1 = (unsigned)(sk_u * s1 + c1_u * 8) * 2u, of2 = (unsigned)(sk_u * INW + c1_u * 8) * 2u;
    const int kq0 = KSWZ(r32, (0 * 16 + hi * 8) * 2), kq1 = KSWZ(r32, (1 * 16 + hi * 8) * 2), kq2 = KSWZ(r32, (2 * 16 + hi * 8) * 2), kq3 = KSWZ(r32, (3 * 16 + hi * 8) * 2);
    const int vrb = (int)(uintptr_t)V_lds + v_rd_base(lnu);
    bf16x8 qr[8];
    { const int ln = lnu;
      const char* qp = (const char*)(Z + (size_t)(row0 + wid * 32) * INW + qcol); const unsigned qo = (unsigned)(r32 * INW + hi * 8) * 2u;
#pragma unroll
      for (int d0 = 0; d0 < 8; ++d0) qr[d0] = *(const bf16x8*)(qp + qo + d0 * 32);
      A_LOAD(0);
      if (mode == 3) { const int t = qb * 256 + wid * 32 + r32; const float* rp0 = rope + ((t >> 6) * 32 + hi * 8) * 2; const float* rp1 = rope + ((t & 63) * 32 + hi * 8) * 2;
          rope_pair(qr[0], qr[2], rp0); rope_pair(qr[1], qr[3], rp0 + 32); rope_pair(qr[4], qr[6], rp1); rope_pair(qr[5], qr[7], rp1 + 32); }
      if (mode == 2) { const int tid = wid * 64 + ln; if (tid < 480) { const int ir = tid >> 5, ic = tid & 31; tbl[tid] = ic < 31 ? a.in[I_RPB][((l * 6 + head) * 15 + ir) * 31 + ic] * 11.313708498984761f : 0.f; } } }
    float m_reg = -1e30f, l_reg = 0.f;
    if (mixB) { m_reg = a.in[I_SINK][l * 6 + head] * 11.313708498984761f; l_reg = 1.f; }
    f32x16 o[4] = {};
    const int qlo = qb * 256 + wid * 32;
    const int rq = 4 * qb + (wid >> 1);
    int stA = rq - 4; stA = stA < 0 ? 0 : (stA > 8 ? 8 : stA);
    constexpr float C2 = 1.4426950408889634f * ATT_SCALE;
    for (int t = 0; t < NT; ++t) {
        const int buf = t & 1;
        const bool local = lat && t >= 4; const int j = j2 + t - 4;
        { if (local && mixB) { const float* rp = rope + (((cg_u >> 2) ? sk_u : j) * 32 + (cg_u & 3) * 8) * 2; rope_pair(st_k0, st_k1, rp); }
          *(LAS bf16x8*)(K_lds + buf * SHM + kw0) = st_k0; *(LAS bf16x8*)(K_lds + buf * SHM + kw1) = st_k1;
          *(LAS bf16x8*)(V_lds + buf * SHM + vw0) = st_v0; *(LAS bf16x8*)(V_lds + buf * SHM + vw1) = st_v1; }
        if (t + 1 < NT) A_LOAD(t + 1);
        __syncthreads();
        bool act = true;
        if (local) { if (!mixB) act = (j >= stA) && (j < stA + 8); else act = (64 * j <= qlo + 31 + 128) && (64 * j + 63 >= qlo - 128); }
        if (act) {
            LAS float* al_l = (LAS float*)(lds + L_WS) + wid * 64 + 32;
            f32x16 p0, p1;
            qkt(p0, p1, K_lds + buf * SHM, kq0, kq1, kq2, kq3, qr);
            if (local) {
                const float NEG = -__builtin_inff();
                if (!mixB) {
                    const int cq = 32 * (wid & 1) + r32; int c0 = cq - 8; c0 = c0 < 0 ? 0 : (c0 > 48 ? 48 : c0);
                    const volatile LAS float* trow = tbl + (j - rq + 7) * 32 + (15 - cq) + 4 * hi; const int kb = 4 * hi - c0;
                    float bv[16];
#pragma unroll
                    for (int r = 0; r < 16; ++r) bv[r] = trow[(r & 3) + 8 * (r >> 2)];
#pragma unroll
                    for (int r = 0; r < 16; ++r) { const int kc = (r & 3) + 8 * (r >> 2); p0[r] = ((unsigned)(kc + kb) < 16u) ? p0[r] + bv[r] : NEG; }
#pragma unroll
                    for (int r = 0; r < 16; ++r) bv[r] = trow[(r & 3) + 8 * (r >> 2) + 32];
#pragma unroll
                    for (int r = 0; r < 16; ++r) { const int kc = (r & 3) + 8 * (r >> 2); p1[r] = ((unsigned)(kc + 32 + kb) < 16u) ? p1[r] + bv[r] : NEG; }
                } else {
                    const int dq = 64 * j + 4 * hi - (qlo + r32) + 128;
#pragma unroll
                    for (int r = 0; r < 16; ++r) { const int kc = (r & 3) + 8 * (r >> 2);
                        p0[r] = ((unsigned)(dq + kc) > 256u) ? NEG : p0[r];
                        p1[r] = ((unsigned)(dq + kc + 32) > 256u) ? NEG : p1[r]; }
                }
            }
            float pmax = p0[0];
#pragma unroll
            for (int r = 1; r < 16; ++r) pmax = fmaxf(pmax, p0[r]);
#pragma unroll
            for (int r = 0; r < 16; ++r) pmax = fmaxf(pmax, p1[r]);
            { auto rr = __builtin_amdgcn_permlane32_swap(__float_as_uint(pmax), __float_as_uint(pmax), false, false); pmax = fmaxf(__uint_as_float(rr[0]), __uint_as_float(rr[1])); }
            float mn = m_reg, alpha = 1.f;
            if (!__all((pmax - m_reg) * ATT_SCALE <= 8.0f)) { mn = fmaxf(m_reg, pmax); alpha = __builtin_amdgcn_exp2f((m_reg - mn) * C2); m_reg = mn; }
            const float mnL = -mn * C2;
            float ps = 0.f;
#pragma unroll
            for (int r = 0; r < 16; ++r) { p0[r] = __builtin_amdgcn_exp2f(fmaf(p0[r], C2, mnL)); p1[r] = __builtin_amdgcn_exp2f(fmaf(p1[r], C2, mnL)); ps += p0[r] + p1[r]; }
            { auto rr = __builtin_amdgcn_permlane32_swap(__float_as_uint(ps), __float_as_uint(ps), false, false); ps = __uint_as_float(rr[0]) + __uint_as_float(rr[1]); }
            l_reg = l_reg * alpha + ps;
            if (__any(alpha < 1.f)) { if (hi == 0) al_l[r32] = alpha; asm volatile("s_waitcnt lgkmcnt(0)" ::: "memory");
#pragma unroll
                for (int r = 0; r < 16; ++r) { const float av = al_l[crow(r, hi)];
#pragma unroll
                    for (int d_ = 0; d_ < 4; ++d_) o[d_][r] *= av; } }
            bf16x8 pa0, pa1, pa2, pa3;
#define PK4(P, B_, OUT) do { unsigned a0 = cvtpk(P[B_ + 0], P[B_ + 1]), a1 = cvtpk(P[B_ + 2], P[B_ + 3]); unsigned b0 = cvtpk(P[B_ + 4], P[B_ + 5]), b1 = cvtpk(P[B_ + 6], P[B_ + 7]); \
        auto r0 = __builtin_amdgcn_permlane32_swap(a0, b0, false, false); auto r1 = __builtin_amdgcn_permlane32_swap(a1, b1, false, false); \
        v4u w = {r0[0], r1[0], r0[1], r1[1]}; OUT = __builtin_bit_cast(bf16x8, w); } while (0)
            PK4(p0, 0, pa0); PK4(p0, 8, pa1); PK4(p1, 0, pa2); PK4(p1, 8, pa3);
#undef PK4
            pv_tile(o, vrb + buf * SHM, pa0, pa1, pa2, pa3);
        }
    }
#undef A_LOAD
    { int ln = lane_in; LAUNDER(ln); const int r32 = ln & 31, hi = ln >> 5;
      LAS float* li_l = (LAS float*)(lds + L_WS) + wid * 64;
      if (hi == 0) li_l[r32] = l_reg; asm volatile("s_waitcnt lgkmcnt(0)" ::: "memory");
      LAS unsigned char* ost = lds + L_OST + wid * OST_WAVE;
#pragma unroll
      for (int r = 0; r < 16; ++r) { const int orow0 = (r & 3) + 8 * (r >> 2); const float rl = __builtin_amdgcn_rcpf(li_l[orow0 + 4 * hi]);
#pragma unroll
          for (int d0 = 0; d0 < 4; ++d0) *(LAS unsigned short*)(ost + (orow0 + 4 * hi) * OST_PITCH + (d0 * 32 + r32) * 2) = (unsigned short)f2bf(o[d0][r] * rl); }
      asm volatile("s_waitcnt lgkmcnt(0)" ::: "memory");
      char* Ow = (char*)((bf16*)(a.ws + WS_MRG) + (size_t)(row0 + wid * 32) * DM + (mixB ? 768 : 0) + head * 128);
#pragma unroll
      for (int i = 0; i < 8; ++i) { const int row = (ln >> 4) + 4 * i; const v4u w = *(const LAS v4u*)(ost + row * OST_PITCH + (ln & 15) * 16);
          *(v4u*)(Ow + (size_t)row * DM * 2 + (ln & 15) * 16) = w; } }
    __syncthreads();
}
#undef LAUNDER
#undef KSWZ
#undef SBAR

constexpr int GT_PITCH = 136;
__device__ __forceinline__ void gmlp_unit(const Args& a, int l, int unit, LAS unsigned char* lds, int tid, int wave, int lane) {
    const int n = unit >> 2, g = unit & 3, R0 = n * 128;
    const bf16* Z = (const bf16*)(a.ws + WS_Z); bf16* MR = (bf16*)(a.ws + WS_MRG);
    LAS unsigned short* T = (LAS unsigned short*)lds;
    LAS float* ST = (LAS float*)(lds + 128 * GT_PITCH * 2);
    const int fi = lane & 15, kg = lane >> 4, p = wave * 16 + fi;
    bf16x8 wf[4];
    { const float* W = a.in[I_GW] + (size_t)((l * 4 + g) * 128 + p) * 128 + 8 * kg;
#pragma unroll
      for (int ks = 0; ks < 4; ++ks) { const f32x4 x0 = *(const f32x4*)(W + 32 * ks), x1 = *(const f32x4*)(W + 32 * ks + 4);
          v4u w; w.x = att::cvtpk(x0[0], x0[1]); w.y = att::cvtpk(x0[2], x0[3]); w.z = att::cvtpk(x1[0], x1[1]); w.w = att::cvtpk(x1[2], x1[3]); wf[ks] = __builtin_bit_cast(bf16x8, w); } }
    { const int q = tid >> 2, cp = tid & 3; const bf16* zp = Z + (size_t)(R0 + q) * INW + VC_ + cp * 8; v4u vw[16];
#pragma unroll
      for (int i = 0; i < 16; ++i) vw[i] = *(const v4u*)(zp + i * 32);
      float s = 0.f, s2 = 0.f;
#pragma unroll
      for (int i = 0; i < 16; ++i) { const v4u w = vw[i]; const float v[8] = {bflo(w.x), bfhi(w.x), bflo(w.y), bfhi(w.y), bflo(w.z), bfhi(w.z), bflo(w.w), bfhi(w.w)};
#pragma unroll
          for (int e = 0; e < 8; ++e) { s += v[e]; s2 += v[e] * v[e]; } }
      s += __shfl_xor(s, 1); s2 += __shfl_xor(s2, 1); s += __shfl_xor(s, 2); s2 += __shfl_xor(s2, 2);
      const float mean = s * (1.0f / 512.0f), var = s2 * (1.0f / 512.0f) - mean * mean;
      if (cp == 0) { ST[q * 2] = mean; ST[q * 2 + 1] = rsqrtf(var + NORM_EPS); } }
    __syncthreads();
    { const int q = tid >> 2, cp = tid & 3; const float mean = ST[q * 2], rstd = ST[q * 2 + 1];
      const bf16* zp = Z + (size_t)(R0 + q) * INW + VC_ + g * 128 + cp * 32; const float* lg = a.in[I_LNG] + l * 512 + g * 128 + cp * 32; const float* lb = a.in[I_LNB] + l * 512 + g * 128 + cp * 32;
#pragma unroll
      for (int c8 = 0; c8 < 4; ++c8) { const v4u w = *(const v4u*)(zp + c8 * 8);
          const float v[8] = {bflo(w.x), bfhi(w.x), bflo(w.y), bfhi(w.y), bflo(w.z), bfhi(w.z), bflo(w.w), bfhi(w.w)};
#pragma unroll
          for (int e = 0; e < 8; ++e) { const int c = cp * 32 + c8 * 8 + e; const float y = (v[e] - mean) * rstd * lg[c8 * 8 + e] + lb[c8 * 8 + e]; T[c * GT_PITCH + q] = (unsigned short)f2bf(y); } } }
    __syncthreads();
    f32x4 acc[8];
#pragma unroll
    for (int cb = 0; cb < 8; ++cb) acc[cb] = (f32x4){0.f, 0.f, 0.f, 0.f};
#pragma unroll
    for (int cb = 0; cb < 8; ++cb)
#pragma unroll
        for (int ks = 0; ks < 4; ++ks) { const bf16x8 af = *(const LAS bf16x8*)(T + (cb * 16 + fi) * GT_PITCH + 32 * ks + 8 * kg);
            acc[cb] = __builtin_amdgcn_mfma_f32_16x16x32_bf16(af, wf[ks], acc[cb], 0, 0, 0); }
    const float bs = a.in[I_GB][(l * 4 + g) * 128 + p];
#pragma unroll
    for (int cb = 0; cb < 8; ++cb) { const int ch = g * 128 + cb * 16 + 4 * kg; const v2u uw = *(const v2u*)(Z + (size_t)(R0 + p) * INW + UC_ + ch);
        v2u ow; ow.x = att::cvtpk(bflo(uw.x) * (acc[cb][0] + bs), bfhi(uw.x) * (acc[cb][1] + bs)); ow.y = att::cvtpk(bflo(uw.y) * (acc[cb][2] + bs), bfhi(uw.y) * (acc[cb][3] + bs));
        *(v2u*)(MR + (size_t)(R0 + p) * DM + 1536 + ch) = ow; }
    __syncthreads();
}
}
constexpr int N_PHASES = 2 + 7 * DEPTH;
#ifndef MK_SP2
#define MK_SP2 true
#endif
#ifndef MK_ALIGN
#define MK_ALIGN true
#endif
#ifndef MK_REP_T0
#define MK_REP_T0 1
#endif
#ifndef MK_REP_P0
#define MK_REP_P0 1
#endif
#ifndef MK_REP_G1
#define MK_REP_G1 1
#endif
#ifndef MK_REP_MIX
#define MK_REP_MIX 1
#endif
#ifndef MK_REP_G2
#define MK_REP_G2 1
#endif
#ifndef MK_REP_G3
#define MK_REP_G3 1
#endif
#ifndef MK_REP_G4
#define MK_REP_G4 1
#endif
__global__ void __launch_bounds__(NWAVES * 64, 2) fwd_kernel(Args args) {
    extern __shared__ __attribute__((aligned(16))) unsigned char lds_raw[];
    LAS unsigned char* lds = (LAS unsigned char*)lds_raw;
    volatile LAS unsigned* MISC = (volatile LAS unsigned*)(lds + MISC_OFF);
    const int tid = threadIdx.x, G = gridDim.x; const int wave_s = __builtin_amdgcn_readfirstlane(tid >> 6);
    unsigned* ctl = (unsigned*)(args.ws + WS_CTL);
    for (int u = tid; u < (LDS_BYTES - LDSCTL_OFF) / 4; u += NWAVES * 64) ((LAS unsigned*)(lds + LDSCTL_OFF))[u] = 0u;
    __syncthreads();
    XcdBarrier bar = xcd_barrier_post(ctl + CW_BAR, MISC + 8);
    const int lo = args.ph_lo, hi = args.ph_hi;
#define IN(k) (lo <= (k) && (k) < hi)
#define PHASE_IDS() int lane_p = (int)__builtin_amdgcn_mbcnt_hi(~0u, __builtin_amdgcn_mbcnt_lo(~0u, 0u)); asm volatile("" : "+v"(lane_p)); const int wave_p = wave_s, tid_p = wave_s * 64 + lane_p; (void)tid_p; (void)wave_p
#ifndef MK_WGM_G2
#define MK_WGM_G2 4
#endif
#ifndef MK_CONV_FIRST
#define MK_CONV_FIRST 1
#endif
#ifndef MK_WGM_G4
#define MK_WGM_G4 4
#endif
#ifndef MK_WS_TOP
#define MK_WS_TOP 1
#endif
#ifndef MK_REP_SEAM
#define MK_REP_SEAM 0
#endif
#ifndef MK_REP_BAR
#define MK_REP_BAR 1
#endif
#define SEAM(k) do { if ((k) + 1 < hi) { for (int rb_ = 0; rb_ < MK_REP_BAR; ++rb_) xcd_barrier(bar); } } while (0)

    if (IN(0)) { for (int rep = 0; rep < MK_REP_P0; ++rep) { PHASE_IDS(); p0_prologue(args, lds, tid_p, wave_p, lane_p, G); __syncthreads(); } SEAM(0); }
    if (IN(1)) { for (int rep = 0; rep < MK_REP_T0; ++rep) { PHASE_IDS(); thin_phase<0, true>(args, lds, tid_p, wave_p, lane_p, G, nullptr, 0, 0, args.in[I_NMPRE], 1, 0, 0); } SEAM(1); }

    for (int l = 0; l < DEPTH; ++l) {
        const int pb = 2 + 7 * l;
        if (IN(pb + 0)) {
            pg8::Gemm g{(const pg8::bf16_t*)(args.ws + WS_H), (const pg8::bf16_t*)(args.ws + WS_WIN) + (size_t)l * INW * DM, MROWS, INW, DM};
            pg8::StaticOrder S; S.init(MROWS, INW, G, (int)blockIdx.x);
            pg8::EpiWin E{(pg8::bf16_t*)(args.ws + WS_Z), args.out, l};
#if MK_CONV_FIRST
            if (MK_CONV_TAIL && l + 1 < DEPTH) { constexpr int total = (MROWS / 256) * (INW / 256); const int rounds = (total + G - 1) / G, nshort = rounds * G - total, c = (int)blockIdx.x;
                if (nshort == 0) { PHASE_IDS(); p0_convert_layer(args, l + 1, lds, wave_p, lane_p, MK_CONV_ADJ ? c * NWAVES + wave_p : wave_p * G + c, G * NWAVES, 0, MK_CONV_TAIL); __syncthreads(); }
                else if (c >= G - nshort) { PHASE_IDS(); p0_convert_layer(args, l + 1, lds, wave_p, lane_p, MK_CONV_ADJ ? (c - (G - nshort)) * NWAVES + wave_p : wave_p * nshort + (c - (G - nshort)), nshort * NWAVES, 0, MK_CONV_TAIL); __syncthreads(); } }
            for (int rep = 0; rep < MK_REP_G1; ++rep)
            pg8::gemm_phase<pg8::EpiWin, pg8::StaticOrder, MK_ALIGN, MK_SP2>(lds + RING_OFF, g, S, E, wave_s);
#else
            for (int rep = 0; rep < MK_REP_G1; ++rep)
            pg8::gemm_phase<pg8::EpiWin, pg8::StaticOrder, MK_ALIGN, MK_SP2>(lds + RING_OFF, g, S, E, wave_s);
            if (MK_CONV_TAIL && l + 1 < DEPTH) { constexpr int total = (MROWS / 256) * (INW / 256); const int rounds = (total + G - 1) / G, nshort = rounds * G - total, c = (int)blockIdx.x;
                if (nshort == 0) { PHASE_IDS(); p0_convert_layer(args, l + 1, lds, wave_p, lane_p, MK_CONV_ADJ ? c * NWAVES + wave_p : wave_p * G + c, G * NWAVES, 0, MK_CONV_TAIL); }
                else if (c >= G - nshort) { PHASE_IDS(); p0_convert_layer(args, l + 1, lds, wave_p, lane_p, MK_CONV_ADJ ? (c - (G - nshort)) * NWAVES + wave_p : wave_p * nshort + (c - (G - nshort)), nshort * NWAVES, 0, MK_CONV_TAIL); } }
#endif
            SEAM(pb + 0);
        }
        if (IN(pb + 1)) {
            PHASE_IDS();
            for (int rep = 0; rep < MK_REP_MIX; ++rep) {
                unsigned* qctr = ctl + CW_QUEUE + 64 * (l + 4 * rep); volatile LAS unsigned* qw = MISC + 16;
                unsigned tk = 0;
                if (tid_p == 0) qw[0] = __hip_atomic_fetch_add(qctr, 1u, __ATOMIC_RELAXED, __HIP_MEMORY_SCOPE_AGENT);
                __syncthreads(); tk = (unsigned)__builtin_amdgcn_readfirstlane((int)qw[0]); __syncthreads();
                while (tk < (unsigned)att::N_UNITS) {
                    unsigned nx = 0; if (tid_p == 0) nx = __hip_atomic_fetch_add(qctr, 1u, __ATOMIC_RELAXED, __HIP_MEMORY_SCOPE_AGENT);
                    att::attn_unit(args, l, (int)tk, lds + RING_OFF, wave_p, lane_p);
                    if (tid_p == 0) qw[0] = nx;
                    __syncthreads(); tk = (unsigned)__builtin_amdgcn_readfirstlane((int)qw[0]); __syncthreads();
                }
                while (tk < (unsigned)(att::N_UNITS + att::N_GMLP)) {
                    unsigned nx = 0; if (tid_p == 0) nx = __hip_atomic_fetch_add(qctr, 1u, __ATOMIC_RELAXED, __HIP_MEMORY_SCOPE_AGENT);
                    att::gmlp_unit(args, l, (int)tk - att::N_UNITS, lds + RING_OFF, tid_p, wave_p, lane_p);
                    if (tid_p == 0) qw[0] = nx;
                    __syncthreads(); tk = (unsigned)__builtin_amdgcn_readfirstlane((int)qw[0]); __syncthreads();
                }
            }
            SEAM(pb + 1);
        }
        if (IN(pb + 2)) {
            pg8::Gemm g{(const pg8::bf16_t*)(args.ws + WS_MRG), (const pg8::bf16_t*)(args.ws + WS_WOUT) + (size_t)l * DM * DM, MROWS, DM, DM};
            pg8::StaticOrder S; S.init(MROWS, DM, G, (int)blockIdx.x, MK_WGM_G2);
            pg8::EpiBf16 E{(pg8::bf16_t*)(args.ws + WS_F1), DM};
            for (int rep = 0; rep < MK_REP_G2; ++rep) {
            pg8::gemm_phase<pg8::EpiBf16, pg8::StaticOrder, MK_ALIGN, MK_SP2>(lds + RING_OFF, g, S, E, wave_s);
            if (MK_REP_SEAM && rep + 1 < MK_REP_G2) xcd_barrier(bar); }
            SEAM(pb + 2);
        }
        if (IN(pb + 3)) {
            PHASE_IDS(); thin_phase<1, true>(args, lds, tid_p, wave_p, lane_p, G, args.in[I_NMPOST] + l * DM, 2, l, args.in[I_NFPRE] + l * DM, 4, 3, l);
            SEAM(pb + 3);
        }
        if (IN(pb + 4)) {
            pg8::Gemm g{(const pg8::bf16_t*)(args.ws + WS_H), (const pg8::bf16_t*)(args.ws + WS_WGU) + (size_t)l * NGU * DM, MROWS, NGU, DM};
            pg8::StaticOrder S; S.init(MROWS, NGU, G, (int)blockIdx.x);
            pg8::EpiGU E{(pg8::bf16_t*)(args.ws + WS_ACT)};
            for (int rep = 0; rep < MK_REP_G3; ++rep)
            pg8::gemm_phase<pg8::EpiGU, pg8::StaticOrder, MK_ALIGN, MK_SP2>(lds + RING_OFF, g, S, E, wave_s);
            SEAM(pb + 4);
        }
        if (IN(pb + 5)) {
            pg8::Gemm g{(const pg8::bf16_t*)(args.ws + WS_ACT), (const pg8::bf16_t*)(args.ws + WS_WDN) + (size_t)l * DM * DFF, MROWS, DM, DFF};
            pg8::StaticOrder S; S.init(MROWS, DM, G, (int)blockIdx.x, MK_WGM_G4);
            pg8::EpiBf16 E{(pg8::bf16_t*)(args.ws + WS_F2), DM};
            for (int rep = 0; rep < MK_REP_G4; ++rep)
            pg8::gemm_phase<pg8::EpiBf16, pg8::StaticOrder, MK_ALIGN, MK_SP2>(lds + RING_OFF, g, S, E, wave_s);
            SEAM(pb + 5);
        }
        if (IN(pb + 6)) {
            PHASE_IDS();
            if (l + 1 < DEPTH) thin_phase<1, true>(args, lds, tid_p, wave_p, lane_p, G, args.in[I_NFPOST] + l * DM, 5, l, args.in[I_NMPRE] + (l + 1) * DM, 1, 0, l + 1);
            else thin_phase<1, false>(args, lds, tid_p, wave_p, lane_p, G, args.in[I_NFPOST] + l * DM, 5, l, nullptr, 0, 0, 0);
            SEAM(pb + 6);
        }
    }
#undef IN
#undef SEAM
}

#ifndef MK_LAUNCH_MODE
#define MK_LAUNCH_MODE 0
#endif
extern "C" void kernel_launch(void* const* d_in, const int* in_sizes, int n_in, void* d_out, int out_size, void* d_ws, size_t ws_size, hipStream_t stream) {
    static int grid = 0;
    if (grid == 0) {
        if (n_in != N_IN || (size_t)out_size != O_END || ws_size < WS_END) { fprintf(stderr, "kernel_launch: unexpected shapes: n_in %d out %d ws %zu\n", n_in, out_size, ws_size); grid = -1; return; }
        int dev = 0, cus = 0, per_cu = 0;
        if (hipGetDevice(&dev) != hipSuccess || hipDeviceGetAttribute(&cus, hipDeviceAttributeMultiprocessorCount, dev) != hipSuccess) { fprintf(stderr, "kernel_launch: device query failed\n"); grid = -1; return; }
        if (hipFuncSetAttribute((const void*)fwd_kernel, hipFuncAttributeMaxDynamicSharedMemorySize, LDS_BYTES) != hipSuccess) { fprintf(stderr, "kernel_launch: hipFuncSetAttribute failed\n"); grid = -1; return; }
        if (hipOccupancyMaxActiveBlocksPerMultiprocessor(&per_cu, (const void*)fwd_kernel, NWAVES * 64, LDS_BYTES) != hipSuccess || per_cu < 1)
            fprintf(stderr, "kernel_launch: note: occupancy query reports %d workgroups per CU\n", per_cu);
        (void)hipGetLastError();
        grid = cus;
    }
    if (grid < 0) return;
    const size_t ws_shift = MK_WS_TOP ? ((ws_size - WS_END) & ~(size_t)(2 * MiB - 1)) : 0;
    if (hipMemsetAsync((char*)d_ws + ws_shift + WS_CTL, 0, CTL_ZERO_BYTES, stream) != hipSuccess) { fprintf(stderr, "kernel_launch: memset failed\n"); return; }
    Args a{};
    for (int i = 0; i < N_IN; ++i) a.in[i] = (const float*)d_in[i];
    a.out = (float*)d_out; a.ws = (unsigned char*)d_ws + ws_shift;
#if MK_LAUNCH_MODE == 1
    a.ph_lo = 0; a.ph_hi = N_PHASES;
    hipLaunchKernelGGL(fwd_kernel, dim3(grid), dim3(NWAVES * 64), LDS_BYTES, stream, a);
#else
    for (int p = 0; p < N_PHASES; ++p) { a.ph_lo = p; a.ph_hi = p + 1;
        hipLaunchKernelGGL(fwd_kernel, dim3(grid), dim3(NWAVES * 64), LDS_BYTES, stream, a); }
#endif
    const hipError_t le = hipPeekAtLastError();
    if (le != hipSuccess) fprintf(stderr, "kernel_launch: launch failed: %s\n", hipGetErrorName(le));
}
```

```cpp
#include <hip/hip_runtime.h>
#include <cstdio>
#include <cstdint>
#define MK_LAUNCH_MODE 1
constexpr int DM = 2048, DEPTH = 4, NCTX = 8192, MROWS = 16384, INW = 4608, DFF = 5632, NGU = 11264;
constexpr int QA_ = 0, KA_ = 768, VA_ = 1536, QB_ = 2304, KB_ = 3072, VB_ = 3328, UC_ = 3584, VC_ = 4096;
constexpr float ATT_SCALE = 0.08838834764831845f;
constexpr float NORM_EPS = 1e-6f;
constexpr int NWAVES = 8;
enum { I_XP = 0, I_XS, I_CAK, I_CAV, I_CBK, I_CBV, I_C, I_CCTX, I_MODW, I_MODB, I_NMPRE, I_NMPOST, I_NFPRE, I_NFPOST, I_WIN, I_WOUT, I_RPB, I_SINK, I_LNG, I_LNB, I_GW, I_GB, I_WGATE, I_WUP, I_WDOWN, N_IN };
constexpr size_t O_Y = 0, O_AK = 33554432ull, O_AV = 58720256ull, O_BK = 83886080ull, O_BV = 92274688ull, O_END = 100663296ull;
constexpr size_t MiB = 1u << 20;
constexpr size_t WS_CTL = 0, CTL_ZERO_BYTES = 1 * MiB;
constexpr size_t WS_MOD = 1 * MiB;
constexpr size_t WS_ROPE = 3 * MiB;
constexpr size_t WS_CAK = 4 * MiB, WS_CAV = 16 * MiB, WS_CBK = 28 * MiB, WS_CBV = 32 * MiB;
constexpr size_t WS_WIN = 40 * MiB;
constexpr size_t WS_WOUT = 112 * MiB;
constexpr size_t WS_WGU = 144 * MiB;
constexpr size_t WS_WDN = 320 * MiB;
constexpr size_t WS_A = 408 * MiB, WS_B = 472 * MiB;
constexpr size_t WS_H = WS_A;
constexpr size_t WS_Z = WS_B;
constexpr size_t WS_MRG = WS_A;
constexpr size_t WS_F1 = WS_B;
constexpr size_t WS_F2 = WS_A;
constexpr size_t WS_ACT = WS_B;
constexpr size_t WS_XB = 648 * MiB;
constexpr size_t WS_END = 712 * MiB;
constexpr int CW_BAR = 4096;
constexpr int CW_QUEUE = 16384;
constexpr int RING_OFF = 0, RING_BYTES = 131072;
constexpr int LDSCTL_OFF = 143360, MISC_OFF = LDSCTL_OFF + 320;
constexpr int LDS_BYTES = 147456;
static_assert(MISC_OFF + 128 <= LDS_BYTES, "LDS map");

#define GAS __attribute__((address_space(1)))
#define LAS __attribute__((address_space(3)))
typedef unsigned short bf16;
typedef unsigned v4u __attribute__((ext_vector_type(4)));
typedef unsigned v2u __attribute__((ext_vector_type(2)));
typedef float f32x4 __attribute__((ext_vector_type(4)));
typedef short bf16x8 __attribute__((ext_vector_type(8)));
typedef GAS unsigned gu32;
#define RLX_AGENT __ATOMIC_RELAXED, __HIP_MEMORY_SCOPE_AGENT
#define LDS_WAIT() asm volatile("s_waitcnt lgkmcnt(0)" ::: "memory")
#define VM_WAIT() asm volatile("s_waitcnt vmcnt(0)" ::: "memory")
__device__ __forceinline__ unsigned f2bf(float f) { unsigned u = __builtin_bit_cast(unsigned, f); return (u + 0x7fffu + ((u >> 16) & 1u)) >> 16; }
__device__ __forceinline__ unsigned pk2(float lo, float hi) { return f2bf(lo) | (f2bf(hi) << 16); }
__device__ __forceinline__ float bf2f(unsigned short b) { return __uint_as_float(((unsigned)b) << 16); }
__device__ __forceinline__ float bflo(unsigned w) { return __uint_as_float(w << 16); }
__device__ __forceinline__ float bfhi(unsigned w) { return __uint_as_float(w & 0xffff0000u); }
__device__ __forceinline__ float wave_sum(float v) {
#pragma unroll
    for (int o = 1; o < 64; o <<= 1) v += __shfl_xor(v, o);
    return v;
}
__device__ __forceinline__ float wave_max(float v) {
#pragma unroll
    for (int o = 1; o < 64; o <<= 1) v = fmaxf(v, __shfl_xor(v, o));
    return v;
}
__device__ __forceinline__ float fast_sigmoid(float y) { return __builtin_amdgcn_rcpf(1.0f + __builtin_amdgcn_exp2f(-1.4426950408889634f * y)); }
__device__ __forceinline__ float gelu_tanh(float x) { const float y = 0.7978845608028654f * (x + 0.044715f * x * x * x); return x * fast_sigmoid(2.0f * y); }
__device__ __forceinline__ float silu_f(float x) { return x * fast_sigmoid(x); }
#ifndef MK_WGM
#define MK_WGM 8
#endif
namespace pg8 {
#define PG8_LAS __attribute__((address_space(3)))
typedef unsigned short bf16_t;
typedef short bf16x8 __attribute__((ext_vector_type(8)));
typedef float f32x4 __attribute__((ext_vector_type(4)));
typedef unsigned u32x4 __attribute__((ext_vector_type(4)));
constexpr int BM = 256, BK = 64, HALF = 128, HTB = HALF * BK * 2  , STAGE_BYTES = 8 * HTB, NXCD = 8, WGM = MK_WGM;

__host__ __device__ __forceinline__ int lds_byte(int r, int c) { const int st = (r >> 4) * 2 + (c >> 5), rr = r & 15, cc = c & 31, ob = rr * 64 + cc * 2; return st * 1024 + (ob ^ (((ob >> 9) & 1) << 5)); }
__host__ __device__ __forceinline__ void stage_rc(int b, int& R, int& C) { const int st = b / 1024, sb = b % 1024, swz = sb ^ (((sb >> 9) & 1) << 5); R = (st >> 1) * 16 + swz / 64; C = (st & 1) * 32 + (swz % 64) / 2; }
__host__ __device__ __forceinline__ int perm32(int rho) { const int n = rho >> 4, i = rho & 15; return 8 * (i >> 2) + 4 * n + (i & 3); }

struct Unit { int pm, pn; };
struct Gemm { const bf16_t* A; const bf16_t* Bt; int M, N, K; };

struct StaticOrder {
    int nM, nN, nwg, G, c, wgm;
    __host__ __device__ void init(int M, int N, int G_, int c_, int wgm_ = WGM) { nM = M / BM; nN = N / BM; nwg = nM * nN; G = G_; c = c_; wgm = wgm_; }
    __host__ __device__ bool next(int i, Unit& u) const {
        const long L = (long)i * G + c; if (L >= nwg) return false;
        int wgid = (int)L; { const int q = nwg / NXCD, r = nwg % NXCD, xcd = wgid % NXCD, off = wgid / NXCD; wgid = (xcd < r ? xcd * (q + 1) : r * (q + 1) + (xcd - r) * q) + off; }
        const int nig = wgm * nN, gid = wgid / nig, fm = gid * wgm, gsz = (nM - fm) < wgm ? (nM - fm) : wgm;
        u.pm = fm + ((wgid % nig) % gsz); u.pn = (wgid % nig) / gsz; return true;
    }
    __device__ __forceinline__ void a_ready(const Unit&) const {}
    __device__ __forceinline__ void done(const Unit&) const {}
};
__device__ __forceinline__ unsigned cvt_pk_bf16(float lo, float hi) { unsigned r; asm volatile("v_cvt_pk_bf16_f32 %0, %1, %2" : "=v"(r) : "v"(lo), "v"(hi)); return r; }
typedef float f32x2 __attribute__((ext_vector_type(2)));

struct EpiF32 {
    static constexpr bool PERM = false, AFTER_DRAIN = false;
    float* C; int ldc;
    __device__ __forceinline__ void operator()(const f32x4 (&acc)[2][2][4][2], const Unit& u, int wr, int wc, int fr, int fq) const {
        const int row0 = u.pm * BM + wr * 64 + fr, col0 = u.pn * BM + wc * 32 + 4 * fq;
#pragma unroll
        for (int ai = 0; ai < 2; ++ai)
#pragma unroll
            for (int m = 0; m < 4; ++m) { float* rowp = C + (size_t)(row0 + ai * HALF + m * 16) * ldc + col0;
#pragma unroll
                for (int bj = 0; bj < 2; ++bj)
#pragma unroll
                    for (int n = 0; n < 2; ++n) *(f32x4*)(rowp + bj * HALF + n * 16) = acc[ai][bj][m][n]; }
    }
};
struct EpiWin {
    static constexpr bool PERM = true, AFTER_DRAIN = false;
    bf16_t* Z; float* out; int layer;
    __device__ __forceinline__ void operator()(const f32x4 (&acc)[2][2][4][2], const Unit& u, int wr, int wc, int fr, int fq) const {
        const int row0 = u.pm * BM + wr * 64 + fr, colb = u.pn * BM + wc * 32 + 8 * fq;
        const bool act = u.pn >= 14;
        bool kv = false; size_t kvbase = 0; int nh = 6, h0 = 0;
        if (u.pm < 32) {
            if (u.pn >= 3 && u.pn <= 5)      { kv = true; kvbase = 33554432ull; nh = 6; h0 = 2 * (u.pn - 3); }
            else if (u.pn >= 6 && u.pn <= 8) { kv = true; kvbase = 58720256ull; nh = 6; h0 = 2 * (u.pn - 6); }
            else if (u.pn == 12)             { kv = true; kvbase = 83886080ull; nh = 2; h0 = 0; }
            else if (u.pn == 13)             { kv = true; kvbase = 92274688ull; nh = 2; h0 = 0; }
        }
#pragma unroll
        for (int ai = 0; ai < 2; ++ai)
#pragma unroll
            for (int m = 0; m < 4; ++m) { const int row = row0 + ai * HALF + m * 16; bf16_t* rowp = Z + (size_t)row * 4608 + colb;
#pragma unroll
                for (int bj = 0; bj < 2; ++bj) { f32x4 v0 = acc[ai][bj][m][0], v1 = acc[ai][bj][m][1];
                    if (kv) { float* p = out + kvbase + ((((size_t)u.pm * 4 + layer) * nh + h0 + bj) * 256 + (row - u.pm * BM)) * 128 + wc * 32 + 8 * fq;
                        __builtin_nontemporal_store(v0, (f32x4*)p); __builtin_nontemporal_store(v1, (f32x4*)(p + 4)); }
                    if (act) {
#pragma unroll
                        for (int j = 0; j < 4; ++j) { v0[j] = gelu_tanh(v0[j]); v1[j] = gelu_tanh(v1[j]); } }
                    u32x4 w; w.x = cvt_pk_bf16(v0[0], v0[1]); w.y = cvt_pk_bf16(v0[2], v0[3]); w.z = cvt_pk_bf16(v1[0], v1[1]); w.w = cvt_pk_bf16(v1[2], v1[3]);
                    *(u32x4*)(rowp + bj * HALF) = w; } }
    }
};
struct EpiGU {
    static constexpr bool PERM = true, AFTER_DRAIN = false;
    bf16_t* O;
    __device__ __forceinline__ void operator()(const f32x4 (&acc)[2][2][4][2], const Unit& u, int wr, int wc, int fr, int fq) const {
        const int row0 = u.pm * BM + wr * 64 + fr, col0 = u.pn * HALF + wc * 32 + 8 * fq;
#pragma unroll
        for (int ai = 0; ai < 2; ++ai)
#pragma unroll
            for (int m = 0; m < 4; ++m) { bf16_t* rowp = O + (size_t)(row0 + ai * HALF + m * 16) * 5632 + col0;
                f32x4 v0, v1;
#pragma unroll
                for (int j = 0; j < 4; ++j) { v0[j] = silu_f(acc[ai][0][m][0][j]) * acc[ai][1][m][0][j]; v1[j] = silu_f(acc[ai][0][m][1][j]) * acc[ai][1][m][1][j]; }
                u32x4 w; w.x = cvt_pk_bf16(v0[0], v0[1]); w.y = cvt_pk_bf16(v0[2], v0[3]); w.z = cvt_pk_bf16(v1[0], v1[1]); w.w = cvt_pk_bf16(v1[2], v1[3]);
                *(u32x4*)rowp = w; }
    }
};

struct EpiBf16 {
    static constexpr bool PERM = true, AFTER_DRAIN = false;
    bf16_t* O; int ldc;
    __device__ __forceinline__ void operator()(const f32x4 (&acc)[2][2][4][2], const Unit& u, int wr, int wc, int fr, int fq) const {
        const int row0 = u.pm * BM + wr * 64 + fr, col0 = u.pn * BM + wc * 32 + 8 * fq;
#pragma unroll
        for (int ai = 0; ai < 2; ++ai)
#pragma unroll
            for (int m = 0; m < 4; ++m) { bf16_t* rowp = O + (size_t)(row0 + ai * HALF + m * 16) * ldc + col0;
#pragma unroll
                for (int bj = 0; bj < 2; ++bj) { const f32x4 v0 = acc[ai][bj][m][0], v1 = acc[ai][bj][m][1];
                    u32x4 w; w.x = cvt_pk_bf16(v0[0], v0[1]); w.y = cvt_pk_bf16(v0[2], v0[3]); w.z = cvt_pk_bf16(v1[0], v1[1]); w.w = cvt_pk_bf16(v1[2], v1[3]);
                    *(u32x4*)(rowp + bj * HALF) = w; } }
    }
};
template <class Epi, class Sched, bool ALIGN_EPI = false, bool SP2 = false>
__device__ __forceinline__ void gemm_phase(PG8_LAS unsigned char* lds, const Gemm g, const Sched& S, const Epi& E, const int wave_id  ) {
    int tid_l = (int)__builtin_amdgcn_mbcnt_hi(~0u, __builtin_amdgcn_mbcnt_lo(~0u, 0u)); asm volatile("" : "+v"(tid_l)); tid_l += 64 * wave_id;
    const int tid = tid_l, wid = __builtin_amdgcn_readfirstlane(tid >> 6), lane = tid & 63, wr = wid >> 2, wc = wid & 3, fr = lane & 15, fq = lane >> 4;
    const int K = g.K, nt = K / BK;
    unsigned voffA[2], voffB[2];
#pragma unroll
    for (int i = 0; i < 2; ++i) { int R, C; stage_rc(tid * 16 + i * 8192, R, C); const int Rb = Epi::PERM ? ((R & ~31) + perm32(R & 31)) : R;
        voffA[i] = (unsigned)(R * K + C) * 2u; voffB[i] = (unsigned)(Rb * K + C) * 2u; }
    const size_t kstep = (size_t)(BK * 2);
    const size_t hstep = (size_t)HALF * K * 2;
    const size_t tstep = 2 * hstep;
    const unsigned ldsw = (unsigned)wid * 1024u;
    const int aoff = lds_byte(wr * 64 + fr, fq * 8), boff = lds_byte(wc * 32 + fr, fq * 8);
#define PG8_SA(b, h) (((b) * 2 + (h)) * HTB)
#define PG8_SB(b, h) ((4 + (b) * 2 + (h)) * HTB)
#define PG8_STAGE(bufoff, gbase, voff) do { _Pragma("unroll") for (int _i = 0; _i < 2; ++_i) \
        __builtin_amdgcn_global_load_lds((const unsigned*)((const char*)(gbase) + (voff)[_i]), (PG8_LAS unsigned*)(lds + (bufoff) + ldsw + _i * 8192), 16, 0, 0); } while (0)
#define PG8_LDA(dst, b, h) do { _Pragma("unroll") for (int m = 0; m < 4; ++m) _Pragma("unroll") for (int k = 0; k < 2; ++k) dst[m][k] = *(const PG8_LAS bf16x8*)(lds + PG8_SA(b, h) + aoff + m * 2048 + k * 1024); } while (0)
#define PG8_LDB(dst, b, h) do { _Pragma("unroll") for (int n = 0; n < 2; ++n) _Pragma("unroll") for (int k = 0; k < 2; ++k) dst[n][k] = *(const PG8_LAS bf16x8*)(lds + PG8_SB(b, h) + boff + n * 2048 + k * 1024); } while (0)
#define PG8_MMA(ai, bj, At, Bt) do { __builtin_amdgcn_s_setprio(1); _Pragma("unroll") for (int m = 0; m < 4; ++m) _Pragma("unroll") for (int n = 0; n < 2; ++n) _Pragma("unroll") for (int k = 0; k < 2; ++k) \
        acc[ai][bj][m][n] = __builtin_amdgcn_mfma_f32_16x16x32_bf16(Bt[n][k], At[m][k], acc[ai][bj][m][n], 0, 0, 0); __builtin_amdgcn_s_setprio(0); } while (0)
#define PG8_WAIT_V(n) asm volatile("s_waitcnt vmcnt(" #n ")" ::: "memory")
#define PG8_WAIT_L(n) asm volatile("s_waitcnt lgkmcnt(" #n ")" ::: "memory")
#define PG8_BAR __builtin_amdgcn_s_barrier()
#define PG8_SCHED __builtin_amdgcn_sched_barrier(0)
    Unit cur, nxt; int ui = 0;
    if (!S.next(0, cur)) return;
    f32x4 acc[2][2][4][2];
#pragma unroll
    for (int a = 0; a < 2; ++a)
#pragma unroll
        for (int b = 0; b < 2; ++b)
#pragma unroll
            for (int m = 0; m < 4; ++m)
#pragma unroll
                for (int n = 0; n < 2; ++n) acc[a][b][m][n] = (f32x4){0.f, 0.f, 0.f, 0.f};
    bf16x8 At[4][2], B0[2][2], B1[2][2];
    const char* cA = (const char*)g.A + (size_t)cur.pm * tstep; const char* cB = (const char*)g.Bt + (size_t)cur.pn * tstep;
    S.a_ready(cur);
    if constexpr (SP2) {
        PG8_STAGE(PG8_SB(0, 0), cB, voffB); PG8_STAGE(PG8_SB(0, 1), cB + hstep, voffB); PG8_STAGE(PG8_SA(0, 0), cA, voffA); PG8_STAGE(PG8_SA(0, 1), cA + hstep, voffA);
        if (wr == 1) PG8_BAR;
        PG8_WAIT_V(2); PG8_BAR;
        PG8_STAGE(PG8_SB(1, 0), cB + kstep, voffB); PG8_STAGE(PG8_SA(1, 0), cA + kstep, voffA); PG8_STAGE(PG8_SB(1, 1), cB + hstep + kstep, voffB);
        PG8_WAIT_V(6); PG8_BAR;
    } else {
        PG8_STAGE(PG8_SB(0, 0), cB, voffB); PG8_STAGE(PG8_SA(0, 0), cA, voffA); PG8_STAGE(PG8_SB(0, 1), cB + hstep, voffB); PG8_STAGE(PG8_SA(0, 1), cA + hstep, voffA);
        if (wr == 1) PG8_BAR;
        PG8_WAIT_V(4); PG8_BAR;
        PG8_STAGE(PG8_SB(1, 0), cB + kstep, voffB); PG8_STAGE(PG8_SA(1, 0), cA + kstep, voffA); PG8_STAGE(PG8_SB(1, 1), cB + hstep + kstep, voffB);
        PG8_WAIT_V(6); PG8_BAR;
    }
    for (;;) {
        const bool has_next = S.next(ui + 1, nxt);
        const char* nA = has_next ? (const char*)g.A + (size_t)nxt.pm * tstep : cA; const char* nB = has_next ? (const char*)g.Bt + (size_t)nxt.pn * tstep : cB;
        for (int t = 0; t < nt; t += 2) {
            const bool last = (t == nt - 2);
            const char* a1 = cA + (size_t)(t + 1) * kstep;
            const char* a2 = last ? nA : cA + (size_t)(t + 2) * kstep; const char* b2 = last ? nB : cB + (size_t)(t + 2) * kstep;
            const char* a3 = a2 + kstep; const char* b3 = b2 + kstep;
            if (last && has_next) S.a_ready(nxt);
            if constexpr (SP2) {
            PG8_LDB(B0, 0, 0); PG8_LDB(B1, 0, 1); PG8_SCHED; PG8_LDA(At, 0, 0); PG8_STAGE(PG8_SA(1, 1), a1 + hstep, voffA);
            PG8_WAIT_V(8); PG8_WAIT_L(0); PG8_BAR; PG8_MMA(0, 0, At, B0); PG8_MMA(0, 1, At, B1); PG8_BAR; PG8_SCHED;
            PG8_LDA(At, 0, 1); PG8_STAGE(PG8_SB(0, 0), b2, voffB); PG8_STAGE(PG8_SB(0, 1), b2 + hstep, voffB); PG8_STAGE(PG8_SA(0, 0), a2, voffA);
            PG8_WAIT_V(8); PG8_WAIT_L(0); PG8_BAR; PG8_MMA(1, 0, At, B0); PG8_MMA(1, 1, At, B1); PG8_BAR; PG8_SCHED;
            PG8_LDB(B0, 1, 0); PG8_LDB(B1, 1, 1); PG8_SCHED; PG8_LDA(At, 1, 0); PG8_STAGE(PG8_SA(0, 1), a2 + hstep, voffA);
            PG8_WAIT_V(8); PG8_WAIT_L(0); PG8_BAR; PG8_MMA(0, 0, At, B0); PG8_MMA(0, 1, At, B1); PG8_BAR; PG8_SCHED;
            PG8_LDA(At, 1, 1); PG8_STAGE(PG8_SB(1, 0), b3, voffB); PG8_STAGE(PG8_SB(1, 1), b3 + hstep, voffB); PG8_STAGE(PG8_SA(1, 0), a3, voffA);
            PG8_WAIT_V(8); PG8_WAIT_L(0); PG8_BAR; PG8_MMA(1, 0, At, B0); PG8_MMA(1, 1, At, B1); PG8_BAR; PG8_SCHED;
            } else {
            PG8_LDB(B0, 0, 0); PG8_SCHED; PG8_LDA(At, 0, 0); PG8_STAGE(PG8_SA(1, 1), a1 + hstep, voffA);
            PG8_WAIT_L(8); PG8_BAR; PG8_WAIT_L(0); PG8_MMA(0, 0, At, B0); PG8_BAR; PG8_SCHED;
            PG8_LDB(B1, 0, 1); PG8_STAGE(PG8_SB(0, 0), b2, voffB);
            PG8_BAR; PG8_WAIT_L(0); PG8_MMA(0, 1, At, B1); PG8_BAR;
            PG8_LDA(At, 0, 1); PG8_STAGE(PG8_SA(0, 0), a2, voffA);
            PG8_BAR; PG8_WAIT_L(0); PG8_MMA(1, 0, At, B0); PG8_BAR; PG8_SCHED;
            PG8_STAGE(PG8_SB(0, 1), b2 + hstep, voffB);
            PG8_WAIT_V(6); PG8_BAR; PG8_MMA(1, 1, At, B1); PG8_BAR;
            PG8_LDB(B0, 1, 0); PG8_SCHED; PG8_LDA(At, 1, 0); PG8_STAGE(PG8_SA(0, 1), a2 + hstep, voffA);
            PG8_WAIT_L(8); PG8_BAR; PG8_WAIT_L(0); PG8_MMA(0, 0, At, B0); PG8_BAR; PG8_SCHED;
            PG8_LDB(B1, 1, 1); PG8_STAGE(PG8_SB(1, 0), b3, voffB);
            PG8_BAR; PG8_WAIT_L(0); PG8_MMA(0, 1, At, B1); PG8_BAR;
            PG8_LDA(At, 1, 1); PG8_STAGE(PG8_SA(1, 0), a3, voffA);
            PG8_BAR; PG8_WAIT_L(0); PG8_MMA(1, 0, At, B0); PG8_BAR; PG8_SCHED;
            PG8_STAGE(PG8_SB(1, 1), b3 + hstep, voffB);
            PG8_WAIT_V(6); PG8_BAR; PG8_MMA(1, 1, At, B1); PG8_BAR;
            }
        }
        if constexpr (ALIGN_EPI) { if (wr == 0) PG8_BAR; }
        if constexpr (!Epi::AFTER_DRAIN) { E(acc, cur, wr, wc, fr, fq); S.done(cur); }
        if (!has_next) break;
#pragma unroll
        for (int a = 0; a < 2; ++a)
#pragma unroll
            for (int b = 0; b < 2; ++b)
#pragma unroll
                for (int m = 0; m < 4; ++m)
#pragma unroll
                    for (int n = 0; n < 2; ++n) acc[a][b][m][n] = (f32x4){0.f, 0.f, 0.f, 0.f};
        cur = nxt; cA = nA; cB = nB; ++ui;
        if constexpr (ALIGN_EPI) { if (wr == 1) PG8_BAR; }
    }
    PG8_WAIT_V(0);
    if constexpr (!ALIGN_EPI) { if (wr == 0) PG8_BAR; }
    PG8_BAR;
    if constexpr (Epi::AFTER_DRAIN) { E.fused(acc, cur, wr, wc, fr, fq, lds, wid, lane); S.done(cur); }
#undef PG8_SA
#undef PG8_SB
#undef PG8_STAGE
#undef PG8_LDA
#undef PG8_LDB
#undef PG8_MMA
#undef PG8_WAIT_V
#undef PG8_WAIT_L
#undef PG8_BAR
#undef PG8_SCHED
}
}
#define XB_TMO      128
#define XB_XCNT(j)  (256  + 64 * (j))
#define XB_XSUB(j)  (1280 + 64 * (j))
#define XB_XGEN(j)  (2304 + 64 * (j))
#define XB_TOP      3328
#define XB_TOPGEN   3392
#define XCD_BAR_WORDS 3456
#define XB_SPIN_CAP (1u << 18)

__device__ __forceinline__ unsigned xb_ld(unsigned* p)              { return __hip_atomic_load(p, __ATOMIC_RELAXED, __HIP_MEMORY_SCOPE_AGENT); }
__device__ __forceinline__ unsigned xb_add(unsigned* p, unsigned v) { return __hip_atomic_fetch_add(p, v, __ATOMIC_RELAXED, __HIP_MEMORY_SCOPE_AGENT); }
__device__ __forceinline__ unsigned xb_xcc_id() { return (unsigned)__builtin_amdgcn_s_getreg((3 << 11) | 20) & 0xFu; }
#define XB_SPIN(cond, bar) do { unsigned _sp = 0; while (cond) { __builtin_amdgcn_s_sleep(1); \
    if ((++_sp & 255u) == 0u) { if (xb_ld(&(bar)[XB_TMO])) break; if (_sp > XB_SPIN_CAP) { atomicAdd(&(bar)[XB_TMO], 1u); break; } } } } while (0)

struct XcdBarrier {
    unsigned* bar; unsigned x;
    volatile LAS unsigned* st;
};

__device__ __forceinline__ XcdBarrier xcd_barrier_post(unsigned* bar, volatile LAS unsigned* st) {
    XcdBarrier b; b.bar = bar; b.x = xb_xcc_id(); b.st = st;
    if (threadIdx.x == 0) (void)xb_add(&bar[XB_XCNT(b.x)], 1u);
    return b;
}
__device__ __forceinline__ void xcd_barrier_complete(unsigned* bar, unsigned x, unsigned& nloc, unsigned& nx) {
    const unsigned G = gridDim.x * gridDim.y * gridDim.z;
    unsigned sum, cnt, mine, sp = 0u;
    for (;;) {
        sum = 0u; cnt = 0u; mine = 0u;
#pragma unroll
        for (unsigned j = 0; j < 16; ++j) { const unsigned c = xb_ld(&bar[XB_XCNT(j)]); sum += c; cnt += (c > 0u) ? 1u : 0u; mine = (j == x) ? c : mine; }
        if (sum == G) break;
        __builtin_amdgcn_s_sleep(1);
        if ((++sp & 255u) == 0u) { if (xb_ld(&bar[XB_TMO])) break; if (sp > XB_SPIN_CAP) { atomicAdd(&bar[XB_TMO], 1u); break; } }
    }
    nloc = mine > 0u ? mine : 1u; nx = cnt > 0u ? cnt : 1u;
}

__device__ __forceinline__ void xcd_barrier(const XcdBarrier& b) {
    asm volatile("s_waitcnt vmcnt(0)" ::: "memory");
    __syncthreads();
    if (threadIdx.x == 0) {
        unsigned* bar = b.bar;
        __builtin_amdgcn_s_waitcnt(0);
        unsigned nloc = b.st[0], nx = b.st[1];
        if (nloc == 0u) { xcd_barrier_complete(bar, b.x, nloc, nx); b.st[0] = nloc; b.st[1] = nx; }
        const unsigned old = xb_add(&bar[XB_XSUB(b.x)], 1u);
        const unsigned gen = old / nloc;
        if (old + 1u == (gen + 1u) * nloc) {
            __builtin_amdgcn_fence(__ATOMIC_RELEASE, "agent");
            asm volatile("s_waitcnt vmcnt(0)" ::: "memory");
            const unsigned og = xb_add(&bar[XB_TOP], 1u);
            const unsigned tg = og / nx;
            if (og + 1u == (tg + 1u) * nx) xb_add(&bar[XB_TOPGEN], 1u);
            else XB_SPIN(xb_ld(&bar[XB_TOPGEN]) == tg, bar);
            __builtin_amdgcn_fence(__ATOMIC_ACQUIRE, "agent");
            xb_add(&bar[XB_XGEN(b.x)], 1u);
            asm volatile("s_waitcnt vmcnt(0)" ::: "memory");
        } else {
            XB_SPIN(xb_ld(&bar[XB_XGEN(b.x)]) == gen, bar);
            __builtin_amdgcn_fence(__ATOMIC_ACQUIRE, "agent");
            asm volatile("s_waitcnt vmcnt(0)" ::: "memory");
        }
    }
    __syncthreads();
}
struct Args { const float* in[N_IN]; float* out; unsigned char* ws; int ph_lo, ph_hi; };

#ifndef MK_CONV_SAMELAYER
#define MK_CONV_SAMELAYER 1
#endif
#ifndef MK_CONV_ADJ
#define MK_CONV_ADJ 1
#endif
#ifndef MK_CONV_TAIL
#define MK_CONV_TAIL 16
#endif
__device__ __forceinline__ void p0_transpose_item(const float* W, int K, int N, bf16* WT, int dmode, LAS float* scr, int item, int lane) {
    const int nblk = N / 32, kb = item / nblk, nb = item % nblk, k0 = 64 * kb, n0 = 32 * nb;
#pragma unroll 8
    for (int i = 0; i < 32; ++i) { const int kk = 2 * i + (lane >> 5); scr[kk * 33 + (lane & 31)] = W[(size_t)(k0 + kk) * N + n0 + (lane & 31)]; }
    LDS_WAIT(); asm volatile("" ::: "memory");
    const int c = lane & 7;
    const int d0 = dmode == 0 ? n0 : ((n0 >> 7) * 256 + (n0 & 127) + (dmode == 2 ? 128 : 0));
#pragma unroll
    for (int j = 0; j < 4; ++j) { const int n = (lane >> 3) + 8 * j; const LAS float* s = scr + (8 * c) * 33 + n;
        v4u o; o.x = pk2(s[0 * 33], s[1 * 33]); o.y = pk2(s[2 * 33], s[3 * 33]); o.z = pk2(s[4 * 33], s[5 * 33]); o.w = pk2(s[6 * 33], s[7 * 33]);
        *(GAS v4u*)(WT + (size_t)(d0 + n) * K + k0 + 8 * c) = o; }
    LDS_WAIT(); asm volatile("" ::: "memory");
}
#ifndef MODR
#define MODR 8
#endif
__device__ __forceinline__ void p0_mod_unit(const Args& a, int unit, LAS unsigned char* lds, int tid, int wave, int lane) {
    const int l = unit / 48, jb = unit % 48;
    LAS float* S = (LAS float*)lds;
    for (int i = tid; i < 9 * DM; i += NWAVES * 64) { const int mi = i / DM, k = i % DM; const float x = mi == 0 ? a.in[I_CCTX][k] : a.in[I_C][(mi - 1) * DM + k]; S[i] = silu_f(x); }
    __syncthreads();
    const float* W = a.in[I_MODW] + (size_t)l * DM * 12288 + jb * 256 + 4 * lane;
    f32x4 acc[9];
#pragma unroll
    for (int mi = 0; mi < 9; ++mi) acc[mi] = (f32x4){0.f, 0.f, 0.f, 0.f};
    const int kbeg = wave * 256;
    f32x4 wa[MODR], wb[MODR];
#define MOD_FMA(WS, KB) do { _Pragma("unroll") for (int i_ = 0; i_ < MODR; ++i_) { _Pragma("unroll") for (int mi = 0; mi < 9; ++mi) { const float s = S[mi * DM + (KB) + i_]; acc[mi] += WS[i_] * s; } } } while (0)
#pragma unroll
    for (int i = 0; i < MODR; ++i) wa[i] = __builtin_nontemporal_load((const f32x4*)(W + (size_t)(kbeg + i) * 12288));
#pragma unroll 1
    for (int kk = 0; kk < 256; kk += 2 * MODR) {
#pragma unroll
        for (int i = 0; i < MODR; ++i) wb[i] = __builtin_nontemporal_load((const f32x4*)(W + (size_t)(kbeg + kk + MODR + i) * 12288));
        MOD_FMA(wa, kbeg + kk);
        if (kk + 2 * MODR < 256) {
#pragma unroll
            for (int i = 0; i < MODR; ++i) wa[i] = __builtin_nontemporal_load((const f32x4*)(W + (size_t)(kbeg + kk + 2 * MODR + i) * 12288)); }
        MOD_FMA(wb, kbeg + kk + MODR);
    }
#undef MOD_FMA
    __syncthreads();
    LAS float* R = (LAS float*)lds;
#pragma unroll
    for (int mi = 0; mi < 9; ++mi) *(LAS f32x4*)(R + (wave * 9 + mi) * 256 + 4 * lane) = acc[mi];
    __syncthreads();
    float* MOD = (float*)(a.ws + WS_MOD);
    for (int i = tid; i < 9 * 256; i += NWAVES * 64) { const int mi = i >> 8, c = i & 255; float s = 0.f;
#pragma unroll
        for (int w = 0; w < 8; ++w) s += R[(w * 9 + mi) * 256 + c];
        const int j = jb * 256 + c; MOD[((size_t)l * 9 + mi) * 12288 + j] = s + a.in[I_MODB][l * 12288 + j]; }
    __syncthreads();
}
struct ConvItem { const float* src; bf16* dst; int N, K; };
__device__ __forceinline__ ConvItem p0_conv_decode(const Args& a, int l, int it) {
    constexpr int I_IN = (DM / 64) * (INW / 32), I_OUT = (DM / 64) * (DM / 32), I_G = (DM / 64) * (DFF / 32);
    const float* W; bf16* WT; int K, N, dmode, r = it;
    if (r < I_IN) { W = a.in[I_WIN] + (size_t)l * DM * INW; K = DM; N = INW; WT = (bf16*)(a.ws + WS_WIN) + (size_t)l * INW * DM; dmode = 0; }
    else if ((r -= I_IN) < I_OUT) { W = a.in[I_WOUT] + (size_t)l * DM * DM; K = DM; N = DM; WT = (bf16*)(a.ws + WS_WOUT) + (size_t)l * DM * DM; dmode = 0; }
    else if ((r -= I_OUT) < I_G) { W = a.in[I_WGATE] + (size_t)l * DM * DFF; K = DM; N = DFF; WT = (bf16*)(a.ws + WS_WGU) + (size_t)l * NGU * DM; dmode = 1; }
    else if ((r -= I_G) < I_G) { W = a.in[I_WUP] + (size_t)l * DM * DFF; K = DM; N = DFF; WT = (bf16*)(a.ws + WS_WGU) + (size_t)l * NGU * DM; dmode = 2; }
    else { r -= I_G; W = a.in[I_WDOWN] + (size_t)l * DFF * DM; K = DFF; N = DM; WT = (bf16*)(a.ws + WS_WDN) + (size_t)l * DM * DFF; dmode = 0; }
    const int nblk = N / 32, kb = r / nblk, nb = r % nblk, k0 = 64 * kb, n0 = 32 * nb;
    const int d0 = dmode == 0 ? n0 : ((n0 >> 7) * 256 + (n0 & 127) + (dmode == 2 ? 128 : 0));
    ConvItem c; c.src = W + (size_t)k0 * N + n0; c.dst = WT + (size_t)d0 * K + k0; c.N = N; c.K = K; return c;
}
constexpr int CONV_PER_L = (DM / 64) * (INW / 32) + (DM / 64) * (DM / 32) + 2 * (DM / 64) * (DFF / 32) + (DFF / 64) * (DM / 32), CONV_I_IN = (DM / 64) * (INW / 32);
__device__ __forceinline__ void p0_convert_items(const Args& a, int l, LAS unsigned char* lds, int wave, int lane, int gw0, int ngw, int it_lo, int it_hi) {
    LAS float* scr = (LAS float*)(lds + RING_OFF + wave * 16384);
    const int gw = it_lo + gw0;
    if (gw >= it_hi) return;
    float ld[32];
    ConvItem cur = p0_conv_decode(a, l, gw);
    { const float* s = cur.src + (size_t)(lane >> 5) * cur.N + (lane & 31);
#pragma unroll
      for (int i = 0; i < 32; ++i) ld[i] = __builtin_nontemporal_load(s + (size_t)(2 * i) * cur.N);     }
    for (int it = gw;; it += ngw) {
#pragma unroll
        for (int i = 0; i < 32; ++i) scr[(2 * i + (lane >> 5)) * 33 + (lane & 31)] = ld[i];
        LDS_WAIT(); asm volatile("" ::: "memory");
        const bool more = it + ngw < it_hi; ConvItem nxt = cur;
        if (more) { nxt = p0_conv_decode(a, l, it + ngw); const float* s = nxt.src + (size_t)(lane >> 5) * nxt.N + (lane & 31);
#pragma unroll
            for (int i = 0; i < 32; ++i) ld[i] = __builtin_nontemporal_load(s + (size_t)(2 * i) * nxt.N); }
        const int c = lane & 7;
#pragma unroll
        for (int j = 0; j < 4; ++j) { const int n = (lane >> 3) + 8 * j; const LAS float* s = scr + (8 * c) * 33 + n;
            v4u o; o.x = pk2(s[0 * 33], s[1 * 33]); o.y = pk2(s[2 * 33], s[3 * 33]); o.z = pk2(s[4 * 33], s[5 * 33]); o.w = pk2(s[6 * 33], s[7 * 33]);
            __builtin_nontemporal_store(o, (GAS v4u*)(cur.dst + (size_t)n * cur.K + 8 * c)); }
        LDS_WAIT(); asm volatile("" ::: "memory");
        if (!more) break;
        cur = nxt;
    }
}
__device__ __forceinline__ void p0_convert_layer(const Args& a, int l, LAS unsigned char* lds, int wave, int lane, int gw0, int ngw, int sixteenths_lo, int sixteenths_hi) {
    p0_convert_items(a, l, lds, wave, lane, gw0, ngw, CONV_PER_L / 16 * sixteenths_lo, sixteenths_hi >= 16 ? CONV_PER_L : CONV_PER_L / 16 * sixteenths_hi);
}
__device__ __forceinline__ void p0_prologue(const Args& a, LAS unsigned char* lds, int tid, int wave, int lane, int G) {
    const int bid = blockIdx.x;
    for (int u = bid; u < 192; u += G) p0_mod_unit(a, u, lds, tid, wave, lane);
    { const int gt = bid * (NWAVES * 64) + tid; if (gt < 2048) { const int pos = gt >> 5, i = gt & 31; const float fr = exp2f(-(float)i * (13.287712379549449f / 32.0f)); const float ang = (float)pos * fr;
        float* R = (float*)(a.ws + WS_ROPE); R[gt * 2] = cosf(ang); R[gt * 2 + 1] = sinf(ang); } }
    { const size_t gt = (size_t)bid * (NWAVES * 64) + tid, nthr = (size_t)G * NWAVES * 64;
      const size_t n8a = 6291456 / 8, n8b = 2097152 / 8;
      for (size_t i = gt; i < 2 * n8a + 2 * n8b; i += nthr) {
          const float* src; bf16* dst; size_t j = i;
          if (j < n8a) { src = a.in[I_CAK]; dst = (bf16*)(a.ws + WS_CAK); }
          else if ((j -= n8a) < n8a) { src = a.in[I_CAV]; dst = (bf16*)(a.ws + WS_CAV); }
          else if ((j -= n8a) < n8b) { src = a.in[I_CBK]; dst = (bf16*)(a.ws + WS_CBK); }
          else { j -= n8b; src = a.in[I_CBV]; dst = (bf16*)(a.ws + WS_CBV); }
          const f32x4 x0 = __builtin_nontemporal_load((const f32x4*)(src + j * 8)), x1 = __builtin_nontemporal_load((const f32x4*)(src + j * 8 + 4));
          v4u o; o.x = pk2(x0[0], x0[1]); o.y = pk2(x0[2], x0[3]); o.z = pk2(x1[0], x1[1]); o.w = pk2(x1[2], x1[3]);
          *(v4u*)(dst + j * 8) = o; } }
#if MK_CONV_SAMELAYER
    p0_convert_items(a, 0, lds, wave, lane, bid * NWAVES + wave, G * NWAVES, 0, CONV_I_IN);
#else
    for (int l = 0; l < DEPTH; ++l) p0_convert_layer(a, l, lds, wave, lane, MK_CONV_ADJ ? bid * NWAVES + wave : wave * G + bid, G * NWAVES, l == 0 ? 0 : MK_CONV_TAIL, 16);
#endif
}

#ifndef MK_XBF16
#define MK_XBF16 1
#endif
struct ThinRow { v4u f[4]; f32x4 x[8]; v4u xb[4]; };
template <int MODE>
__device__ __forceinline__ void thin_load(ThinRow& r, const Args& a, int row, int lane, size_t f_off) {
    if (MODE == 0 || !MK_XBF16) {
        const float* xs = MODE == 0 ? (row < NCTX ? a.in[I_XP] + (size_t)row * DM : a.in[I_XS] + (size_t)(row - NCTX) * DM) : a.out + (size_t)row * DM;
#pragma unroll
        for (int j = 0; j < 4; ++j) { if (MODE == 0) { r.x[2 * j] = __builtin_nontemporal_load((const f32x4*)(xs + 8 * lane + 512 * j)); r.x[2 * j + 1] = __builtin_nontemporal_load((const f32x4*)(xs + 8 * lane + 512 * j + 4)); }
            else { r.x[2 * j] = *(const f32x4*)(xs + 8 * lane + 512 * j); r.x[2 * j + 1] = *(const f32x4*)(xs + 8 * lane + 512 * j + 4); } }
    } else { const bf16* xs = (const bf16*)(a.ws + WS_XB) + (size_t)row * DM;
#pragma unroll
        for (int j = 0; j < 4; ++j) r.xb[j] = *(const v4u*)(xs + 8 * lane + 512 * j); }
    if (MODE == 1) { const bf16* fs = (const bf16*)(a.ws + f_off) + (size_t)row * DM;
#pragma unroll
        for (int j = 0; j < 4; ++j) r.f[j] = __builtin_nontemporal_load((const v4u*)(fs + 8 * lane + 512 * j)); }
}
__device__ __forceinline__ void unpack8f(const v4u w, f32x4& a, f32x4& b) { a = (f32x4){bflo(w.x), bfhi(w.x), bflo(w.y), bfhi(w.y)}; b = (f32x4){bflo(w.z), bfhi(w.z), bflo(w.w), bfhi(w.w)}; }
template <int MODE, bool HAS_H>
__device__ __forceinline__ void thin_phase(const Args& a, LAS unsigned char* lds, int tid, int wave, int lane, int G, const float* gpost, int gate_sel, int lgate, const float* gpre, int scale_sel, int shift_sel, int lnext) {
    const size_t f_off = gate_sel == 5 ? WS_F2 : WS_F1;
    float* X = a.out; bf16* XB = (bf16*)(a.ws + WS_XB); bf16* H = (bf16*)(a.ws + WS_H); const float* MOD = (const float*)(a.ws + WS_MOD);
    constexpr bool XOUT_BF = MK_XBF16 && HAS_H;
    LAS float* VG = (LAS float*)lds; LAS float* VW = VG + DM; LAS float* VS = VW + DM;
    for (int chunk = blockIdx.x; chunk < MROWS / 64; chunk += G) {
        const int r0 = chunk * 64, mi = r0 < NCTX ? 0 : 1 + ((r0 - NCTX) >> 10);
        { const int c = 4 * tid;
          if (MODE == 1) { const f32x4 gt = *(const f32x4*)(MOD + ((size_t)lgate * 9 + mi) * 12288 + gate_sel * DM + c), gp = *(const f32x4*)(gpost + c); *(LAS f32x4*)(VG + c) = gt * gp; }
          if (HAS_H) { const f32x4 gp = *(const f32x4*)(gpre + c), s1 = *(const f32x4*)(MOD + ((size_t)lnext * 9 + mi) * 12288 + scale_sel * DM + c), s0 = *(const f32x4*)(MOD + ((size_t)lnext * 9 + mi) * 12288 + shift_sel * DM + c);
              *(LAS f32x4*)(VW + c) = gp * (s1 + 1.0f); *(LAS f32x4*)(VS + c) = s0; } }
        ThinRow cur, nxt;
        const int rw = r0 + wave * 8;
        thin_load<MODE>(cur, a, rw, lane, f_off);
        __syncthreads();
        for (int k = 0; k < 8; ++k) {
            const int row = rw + k;
            if (k + 1 < 8) thin_load<MODE>(nxt, a, row + 1, lane, f_off);
            f32x4 x[8];
            if (MODE == 0) {
#pragma unroll
                for (int j = 0; j < 8; ++j) x[j] = cur.x[j];
            } else {
                f32x4 f[8], xo[8]; float ss = 0.f;
#pragma unroll
                for (int j = 0; j < 4; ++j) { unpack8f(cur.f[j], f[2 * j], f[2 * j + 1]); if (MK_XBF16) unpack8f(cur.xb[j], xo[2 * j], xo[2 * j + 1]); else { xo[2 * j] = cur.x[2 * j]; xo[2 * j + 1] = cur.x[2 * j + 1]; } }
#pragma unroll
                for (int j = 0; j < 8; ++j) ss += (f[j][0] * f[j][0] + f[j][1] * f[j][1]) + (f[j][2] * f[j][2] + f[j][3] * f[j][3]);
                const float rstd = rsqrtf(wave_sum(ss) * (1.0f / DM) + NORM_EPS);
#pragma unroll
                for (int j = 0; j < 8; ++j) { const int c = 8 * lane + 512 * (j >> 1) + 4 * (j & 1); const f32x4 gg = *(const LAS f32x4*)(VG + c); x[j] = xo[j] + gg * (f[j] * rstd); }
            }
            if (XOUT_BF) {
#pragma unroll
                for (int j = 0; j < 4; ++j) { v4u o; o.x = pk2(x[2 * j][0], x[2 * j][1]); o.y = pk2(x[2 * j][2], x[2 * j][3]); o.z = pk2(x[2 * j + 1][0], x[2 * j + 1][1]); o.w = pk2(x[2 * j + 1][2], x[2 * j + 1][3]);
                    *(v4u*)(XB + (size_t)row * DM + 8 * lane + 512 * j) = o; }
            } else {
#pragma unroll
                for (int j = 0; j < 8; ++j) { if (MK_XBF16) __builtin_nontemporal_store(x[j], (f32x4*)(X + (size_t)row * DM + 8 * lane + 512 * (j >> 1) + 4 * (j & 1))); else *(f32x4*)(X + (size_t)row * DM + 8 * lane + 512 * (j >> 1) + 4 * (j & 1)) = x[j]; }
            }
            if (HAS_H) {
                float ss = 0.f;
#pragma unroll
                for (int j = 0; j < 8; ++j) ss += (x[j][0] * x[j][0] + x[j][1] * x[j][1]) + (x[j][2] * x[j][2] + x[j][3] * x[j][3]);
                const float rstd = rsqrtf(wave_sum(ss) * (1.0f / DM) + NORM_EPS);
#pragma unroll
                for (int j = 0; j < 4; ++j) { const int c = 8 * lane + 512 * j; f32x4 h[2];
#pragma unroll
                    for (int kk = 0; kk < 2; ++kk) { const f32x4 w = *(const LAS f32x4*)(VW + c + 4 * kk), s0 = *(const LAS f32x4*)(VS + c + 4 * kk); h[kk] = (x[2 * j + kk] * rstd) * w + s0; }
                    v4u o; o.x = pk2(h[0][0], h[0][1]); o.y = pk2(h[0][2], h[0][3]); o.z = pk2(h[1][0], h[1][1]); o.w = pk2(h[1][2], h[1][3]); *(v4u*)(H + (size_t)row * DM + c) = o; }
            }
            if (k + 1 < 8) cur = nxt;
        }
        __syncthreads();
    }
}

namespace att {
typedef short s16x4 __attribute__((ext_vector_type(4)));
typedef float f32x16 __attribute__((ext_vector_type(16)));
constexpr int SHM = 16384;
constexpr int L_V = 0, L_K = 2 * SHM, L_WS = 4 * SHM, L_TBL = L_WS + 2048, L_END = L_TBL + (64 + 480 + 64) * 4;
constexpr int OST_PITCH = 272, L_OST = 73728, OST_WAVE = 32 * OST_PITCH;
static_assert(L_END <= L_OST && L_OST + 8 * OST_WAVE <= LDSCTL_OFF, "attention LDS");
#define KSWZ(row, colB) ((row) * 256 + ((colB) ^ (((row) & 7) << 4)))
#define SBAR() __builtin_amdgcn_sched_barrier(0)
__device__ __forceinline__ int v_st(int k, int c) { const int kk = (k & ~0xC) | ((k & 4) << 1) | ((k & 8) >> 1); return ((kk >> 3) * 4 + (c >> 5)) * 512 + ((kk & 7) * 32 + (c & 31)) * 2; }
__device__ __forceinline__ int v_rd_base(int lane) { return ((lane & 3) << 3) | (((lane >> 2) & 3) << 6) | (((lane >> 4) & 1) << 5) | (((lane >> 5) & 1) << 8); }
constexpr int v_rd_off(int d0, int ks, int half) { return d0 * 512 + ks * 4096 + half * 2048; }
__device__ __forceinline__ int crow(int r, int hi) { return (r & 3) + 8 * (r >> 2) + 4 * hi; }
__device__ __forceinline__ unsigned cvtpk(float lo, float hi) { unsigned r; asm volatile("v_cvt_pk_bf16_f32 %0, %1, %2" : "=v"(r) : "v"(lo), "v"(hi)); return r; }
__device__ __forceinline__ void rope_pair(bf16x8& a, bf16x8& b, const float* rp) {
    const v4u wa = __builtin_bit_cast(v4u, a), wb = __builtin_bit_cast(v4u, b);
    const float x1[8] = {bflo(wa.x), bfhi(wa.x), bflo(wa.y), bfhi(wa.y), bflo(wa.z), bfhi(wa.z), bflo(wa.w), bfhi(wa.w)};
    const float x2[8] = {bflo(wb.x), bfhi(wb.x), bflo(wb.y), bfhi(wb.y), bflo(wb.z), bfhi(wb.z), bflo(wb.w), bfhi(wb.w)};
    const f32x4 c0 = *(const f32x4*)rp, c1 = *(const f32x4*)(rp + 4), c2 = *(const f32x4*)(rp + 8), c3 = *(const f32x4*)(rp + 12);
    const float cs[16] = {c0[0], c0[1], c0[2], c0[3], c1[0], c1[1], c1[2], c1[3], c2[0], c2[1], c2[2], c2[3], c3[0], c3[1], c3[2], c3[3]};
    float y1[8], y2[8];
#pragma unroll
    for (int e = 0; e < 8; ++e) { const float c = cs[2 * e], s = cs[2 * e + 1]; y1[e] = x1[e] * c - x2[e] * s; y2[e] = x1[e] * s + x2[e] * c; }
    v4u oa, ob; oa.x = cvtpk(y1[0], y1[1]); oa.y = cvtpk(y1[2], y1[3]); oa.z = cvtpk(y1[4], y1[5]); oa.w = cvtpk(y1[6], y1[7]);
    ob.x = cvtpk(y2[0], y2[1]); ob.y = cvtpk(y2[2], y2[3]); ob.z = cvtpk(y2[4], y2[5]); ob.w = cvtpk(y2[6], y2[7]);
    a = __builtin_bit_cast(bf16x8, oa); b = __builtin_bit_cast(bf16x8, ob);
}
__device__ __forceinline__ void qkt(f32x16& p0, f32x16& p1, const LAS unsigned char* Kt, int kq0, int kq1, int kq2, int kq3, const bf16x8* qr) {
    p0 = f32x16{}; p1 = f32x16{};
    const LAS unsigned char* kb[4] = {Kt + kq0, Kt + kq1, Kt + kq2, Kt + kq3};
#pragma unroll
    for (int d0 = 0; d0 < 8; ++d0) { const LAS unsigned char* ap = kb[d0 & 3] + (d0 >> 2) * 128;
        const bf16x8 b0 = *(const LAS bf16x8*)ap;
        const bf16x8 b1 = *(const LAS bf16x8*)(ap + 32 * 256);
        p0 = __builtin_amdgcn_mfma_f32_32x32x16_bf16(b0, qr[d0], p0, 0, 0, 0);
        p1 = __builtin_amdgcn_mfma_f32_32x32x16_bf16(b1, qr[d0], p1, 0, 0, 0); }
}
__device__ __forceinline__ void pv_tile(f32x16* o, int vb0, bf16x8 pa0, bf16x8 pa1, bf16x8 pa2, bf16x8 pa3) {
#define TRRD(dst, off) asm volatile("ds_read_b64_tr_b16 %0, %1 offset:%2" : "=&v"(dst) : "v"(vb0), "i"(off) : "memory")
#define PV_RD(S, d0) do { constexpr int b_ = v_rd_off(d0, 0, 0); TRRD(S##l0, b_); TRRD(S##h0, b_ + 2048); TRRD(S##l1, b_ + 4096); TRRD(S##h1, b_ + 6144); TRRD(S##l2, b_ + 8192); TRRD(S##h2, b_ + 10240); TRRD(S##l3, b_ + 12288); TRRD(S##h3, b_ + 14336); } while (0)
#define PV_MM(S, d0) do { \
        o[d0] = __builtin_amdgcn_mfma_f32_32x32x16_bf16(pa0, (bf16x8){S##l0[0], S##l0[1], S##l0[2], S##l0[3], S##h0[0], S##h0[1], S##h0[2], S##h0[3]}, o[d0], 0, 0, 0); \
        o[d0] = __builtin_amdgcn_mfma_f32_32x32x16_bf16(pa1, (bf16x8){S##l1[0], S##l1[1], S##l1[2], S##l1[3], S##h1[0], S##h1[1], S##h1[2], S##h1[3]}, o[d0], 0, 0, 0); \
        o[d0] = __builtin_amdgcn_mfma_f32_32x32x16_bf16(pa2, (bf16x8){S##l2[0], S##l2[1], S##l2[2], S##l2[3], S##h2[0], S##h2[1], S##h2[2], S##h2[3]}, o[d0], 0, 0, 0); \
        o[d0] = __builtin_amdgcn_mfma_f32_32x32x16_bf16(pa3, (bf16x8){S##l3[0], S##l3[1], S##l3[2], S##l3[3], S##h3[0], S##h3[1], S##h3[2], S##h3[3]}, o[d0], 0, 0, 0); } while (0)
    s16x4 Al0, Al1, Al2, Al3, Ah0, Ah1, Ah2, Ah3, Bl0, Bl1, Bl2, Bl3, Bh0, Bh1, Bh2, Bh3;
    PV_RD(A, 0); PV_RD(B, 1);
    asm volatile("s_waitcnt lgkmcnt(8)" ::: "memory"); SBAR(); PV_MM(A, 0); SBAR();
    PV_RD(A, 2);
    asm volatile("s_waitcnt lgkmcnt(8)" ::: "memory"); SBAR(); PV_MM(B, 1); SBAR();
    PV_RD(B, 3);
    asm volatile("s_waitcnt lgkmcnt(8)" ::: "memory"); SBAR(); PV_MM(A, 2); SBAR();
    asm volatile("s_waitcnt lgkmcnt(0)" ::: "memory"); SBAR(); PV_MM(B, 3);
#undef PV_MM
#undef PV_RD
#undef TRRD
}
constexpr int N_UNITS = 768, N_GMLP = 512;
#define LAUNDER(v) asm volatile("" : "+v"(v))
__device__ __forceinline__ void attn_unit(const Args& a, int l, int u, LAS unsigned char* lds, int wid, int lane_in) {
    int mode, b, head, qb = 0;
    if (u < 384) { const int v = u % 96, k = u / 96; mode = 2 + (k & 1); b = v / 12; head = (v % 12) >> 1; qb = k < 2 ? 1 + (v & 1) : ((v & 1) ? 3 : 0); }
    else if (u < 576) { const int v = u - 384; mode = 0; b = v / 6; head = v % 6; }
    else { const int v = u - 576; mode = 1; b = v / 6; head = v % 6; }
    const bool lat = mode >= 2, mixB = (mode & 1) != 0;
    const int g = head / 3;
    const int qcol = mixB ? QB_ + head * 128 : QA_ + head * 128, kcol = mixB ? KB_ + g * 128 : KA_ + head * 128, vcol = mixB ? VB_ + g * 128 : VA_ + head * 128;
    const int seq0 = lat ? NCTX + b * 1024 : b * 256, row0 = seq0 + qb * 256;
    const bf16* Z = (const bf16*)(a.ws + WS_Z); const float* rope = (const float*)(a.ws + WS_ROPE);
    const char *K1, *V1, *K2 = nullptr, *V2 = nullptr; int s1, n2 = 0, j2 = 0;
    if (!lat) { K1 = (const char*)(Z + (size_t)seq0 * INW + kcol); V1 = (const char*)(Z + (size_t)seq0 * INW + vcol); s1 = INW; }
    else {
        if (!mixB) { const size_t co = (size_t)((b * 4 + l) * 6 + head) * 256 * 128; K1 = (const char*)((const bf16*)(a.ws + WS_CAK) + co); V1 = (const char*)((const bf16*)(a.ws + WS_CAV) + co); }
        else { const size_t co = (size_t)((b * 4 + l) * 2 + g) * 256 * 128; K1 = (const char*)((const bf16*)(a.ws + WS_CBK) + co); V1 = (const char*)((const bf16*)(a.ws + WS_CBV) + co); }
        s1 = 128; K2 = (const char*)(Z + (size_t)seq0 * INW + kcol); V2 = (const char*)(Z + (size_t)seq0 * INW + vcol);
        if (!mixB) { j2 = qb <= 1 ? 0 : (qb == 2 ? 4 : 8); n2 = (qb == 0 || qb == 3) ? 8 : 11; }
        else { j2 = 4 * qb - 2 < 0 ? 0 : 4 * qb - 2; const int je = 4 * qb + 6 > 16 ? 16 : 4 * qb + 6; n2 = je - j2; }
    }
    const int NT = 4 + n2;
    LAS unsigned char* V_lds = lds + L_V; LAS unsigned char* K_lds = lds + L_K;
    LAS float* tbl = (LAS float*)(lds + L_TBL) + 64;
    bf16x8 st_k0, st_k1, st_v0, st_v1;
#define A_LOAD(t) do { const char* kp_; const char* vp_; unsigned of_; \
        if ((t) < 4) { kp_ = K1 + (size_t)(t) * 64 * s1 * 2; vp_ = V1 + (size_t)(t) * 64 * s1 * 2; of_ = of1; } \
        else { kp_ = K2 + (size_t)(j2 + (t) - 4) * 64 * INW * 2; vp_ = V2 + (size_t)(j2 + (t) - 4) * 64 * INW * 2; of_ = of2; } \
        st_k0 = *(const bf16x8*)(kp_ + of_); st_k1 = *(const bf16x8*)(kp_ + of_ + 64); st_v0 = *(const bf16x8*)(vp_ + of_); st_v1 = *(const bf16x8*)(vp_ + of_ + 64); } while (0)
    int lnu = lane_in; LAUNDER(lnu);
    const int tid_u = wid * 64 + lnu, sk_u = tid_u >> 3, cg_u = tid_u & 7, c1_u = (cg_u >> 2) * 8 + (cg_u & 3), r32 = lnu & 31, hi = lnu >> 5;
    const int kw0 = KSWZ(sk_u, c1_u * 16), kw1 = KSWZ(sk_u, (c1_u + 4) * 16), vw0 = v_st(sk_u, c1_u * 8), vw1 = v_st(sk_u, c1_u * 8 + 32);
    const unsigned of1 = (unsigned)(sk_u * s1 + c1_u * 8) * 2u, of2 = (unsigned)(sk_u * INW + c1_u * 8) * 2u;
    const int kq0 = KSWZ(r32, (0 * 16 + hi * 8) * 2), kq1 = KSWZ(r32, (1 * 16 + hi * 8) * 2), kq2 = KSWZ(r32, (2 * 16 + hi * 8) * 2), kq3 = KSWZ(r32, (3 * 16 + hi * 8) * 2);
    const int vrb = (int)(uintptr_t)V_lds + v_rd_base(lnu);
    bf16x8 qr[8];
    { const int ln = lnu;
      const char* qp = (const char*)(Z + (size_t)(row0 + wid * 32) * INW + qcol); const unsigned qo = (unsigned)(r32 * INW + hi * 8) * 2u;
#pragma unroll
      for (int d0 = 0; d0 < 8; ++d0) qr[d0] = *(const bf16x8*)(qp + qo + d0 * 32);
      A_LOAD(0);
      if (mode == 3) { const int t = qb * 256 + wid * 32 + r32; const float* rp0 = rope + ((t >> 6) * 32 + hi * 8) * 2; const float* rp1 = rope + ((t & 63) * 32 + hi * 8) * 2;
          rope_pair(qr[0], qr[2], rp0); rope_pair(qr[1], qr[3], rp0 + 32); rope_pair(qr[4], qr[6], rp1); rope_pair(qr[5], qr[7], rp1 + 32); }
      if (mode == 2) { const int tid = wid * 64 + ln; if (tid < 480) { const int ir = tid >> 5, ic = tid & 31; tbl[tid] = ic < 31 ? a.in[I_RPB][((l * 6 + head) * 15 + ir) * 31 + ic] * 11.313708498984761f : 0.f; } } }
    float m_reg = -1e30f, l_reg = 0.f;
    if (mixB) { m_reg = a.in[I_SINK][l * 6 + head] * 11.313708498984761f; l_reg = 1.f; }
    f32x16 o[4] = {};
    const int qlo = qb * 256 + wid * 32;
    const int rq = 4 * qb + (wid >> 1);
    int stA = rq - 4; stA = stA < 0 ? 0 : (stA > 8 ? 8 : stA);
    constexpr float C2 = 1.4426950408889634f * ATT_SCALE;
    for (int t = 0; t < NT; ++t) {
        const int buf = t & 1;
        const bool local = lat && t >= 4; const int j = j2 + t - 4;
        { if (local && mixB) { const float* rp = rope + (((cg_u >> 2) ? sk_u : j) * 32 + (cg_u & 3) * 8) * 2; rope_pair(st_k0, st_k1, rp); }
          *(LAS bf16x8*)(K_lds + buf * SHM + kw0) = st_k0; *(LAS bf16x8*)(K_lds + buf * SHM + kw1) = st_k1;
          *(LAS bf16x8*)(V_lds + buf * SHM + vw0) = st_v0; *(LAS bf16x8*)(V_lds + buf * SHM + vw1) = st_v1; }
        if (t + 1 < NT) A_LOAD(t + 1);
        __syncthreads();
        bool act = true;
        if (local) { if (!mixB) act = (j >= stA) && (j < stA + 8); else act = (64 * j <= qlo + 31 + 128) && (64 * j + 63 >= qlo - 128); }
        if (act) {
            LAS float* al_l = (LAS float*)(lds + L_WS) + wid * 64 + 32;
            f32x16 p0, p1;
            qkt(p0, p1, K_lds + buf * SHM, kq0, kq1, kq2, kq3, qr);
            if (local) {
                const float NEG = -__builtin_inff();
                if (!mixB) {
                    const int cq = 32 * (wid & 1) + r32; int c0 = cq - 8; c0 = c0 < 0 ? 0 : (c0 > 48 ? 48 : c0);
                    const volatile LAS float* trow = tbl + (j - rq + 7) * 32 + (15 - cq) + 4 * hi; const int kb = 4 * hi - c0;
                    float bv[16];
#pragma unroll
                    for (int r = 0; r < 16; ++r) bv[r] = trow[(r & 3) + 8 * (r >> 2)];
#pragma unroll
                    for (int r = 0; r < 16; ++r) { const int kc = (r & 3) + 8 * (r >> 2); p0[r] = ((unsigned)(kc + kb) < 16u) ? p0[r] + bv[r] : NEG; }
#pragma unroll
                    for (int r = 0; r < 16; ++r) bv[r] = trow[(r & 3) + 8 * (r >> 2) + 32];
#pragma unroll
                    for (int r = 0; r < 16; ++r) { const int kc = (r & 3) + 8 * (r >> 2); p1[r] = ((unsigned)(kc + 32 + kb) < 16u) ? p1[r] + bv[r] : NEG; }
                } else {
                    const int dq = 64 * j + 4 * hi - (qlo + r32) + 128;
#pragma unroll
                    for (int r = 0; r < 16; ++r) { const int kc = (r & 3) + 8 * (r >> 2);
                        p0[r] = ((unsigned)(dq + kc) > 256u) ? NEG : p0[r];
                        p1[r] = ((unsigned)(dq + kc + 32) > 256u) ? NEG : p1[r]; }
                }
            }
            float pmax = p0[0];
#pragma unroll
            for (int r = 1; r < 16; ++r) pmax = fmaxf(pmax, p0[r]);
#pragma unroll
            for (int r = 0; r < 16; ++r) pmax = fmaxf(pmax, p1[r]);
            { auto rr = __builtin_amdgcn_permlane32_swap(__float_as_uint(pmax), __float_as_uint(pmax), false, false); pmax = fmaxf(__uint_as_float(rr[0]), __uint_as_float(rr[1])); }
            float mn = m_reg, alpha = 1.f;
            if (!__all((pmax - m_reg) * ATT_SCALE <= 8.0f)) { mn = fmaxf(m_reg, pmax); alpha = __builtin_amdgcn_exp2f((m_reg - mn) * C2); m_reg = mn; }
            const float mnL = -mn * C2;
            float ps = 0.f;
#pragma unroll
            for (int r = 0; r < 16; ++r) { p0[r] = __builtin_amdgcn_exp2f(fmaf(p0[r], C2, mnL)); p1[r] = __builtin_amdgcn_exp2f(fmaf(p1[r], C2, mnL)); ps += p0[r] + p1[r]; }
            { auto rr = __builtin_amdgcn_permlane32_swap(__float_as_uint(ps), __float_as_uint(ps), false, false); ps = __uint_as_float(rr[0]) + __uint_as_float(rr[1]); }
            l_reg = l_reg * alpha + ps;
            if (__any(alpha < 1.f)) { if (hi == 0) al_l[r32] = alpha; asm volatile("s_waitcnt lgkmcnt(0)" ::: "memory");
#pragma unroll
                for (int r = 0; r < 16; ++r) { const float av = al_l[crow(r, hi)];
#pragma unroll
                    for (int d_ = 0; d_ < 4; ++d_) o[d_][r] *= av; } }
            bf16x8 pa0, pa1, pa2, pa3;
#define PK4(P, B_, OUT) do { unsigned a0 = cvtpk(P[B_ + 0], P[B_ + 1]), a1 = cvtpk(P[B_ + 2], P[B_ + 3]); unsigned b0 = cvtpk(P[B_ + 4], P[B_ + 5]), b1 = cvtpk(P[B_ + 6], P[B_ + 7]); \
        auto r0 = __builtin_amdgcn_permlane32_swap(a0, b0, false, false); auto r1 = __builtin_amdgcn_permlane32_swap(a1, b1, false, false); \
        v4u w = {r0[0], r1[0], r0[1], r1[1]}; OUT = __builtin_bit_cast(bf16x8, w); } while (0)
            PK4(p0, 0, pa0); PK4(p0, 8, pa1); PK4(p1, 0, pa2); PK4(p1, 8, pa3);
#undef PK4
            pv_tile(o, vrb + buf * SHM, pa0, pa1, pa2, pa3);
        }
    }
#undef A_LOAD
    { int ln = lane_in; LAUNDER(ln); const int r32 = ln & 31, hi = ln >> 5;
      LAS float* li_l = (LAS float*)(lds + L_WS) + wid * 64;
      if (hi == 0) li_l[r32] = l_reg; asm volatile("s_waitcnt lgkmcnt(0)" ::: "memory");
      LAS unsigned char* ost = lds + L_OST + wid * OST_WAVE;
#pragma unroll
      for (int r = 0; r < 16; ++r) { const int orow0 = (r & 3) + 8 * (r >> 2); const float rl = __builtin_amdgcn_rcpf(li_l[orow0 + 4 * hi]);
#pragma unroll
          for (int d0 = 0; d0 < 4; ++d0) *(LAS unsigned short*)(ost + (orow0 + 4 * hi) * OST_PITCH + (d0 * 32 + r32) * 2) = (unsigned short)f2bf(o[d0][r] * rl); }
      asm volatile("s_waitcnt lgkmcnt(0)" ::: "memory");
      char* Ow = (char*)((bf16*)(a.ws + WS_MRG) + (size_t)(row0 + wid * 32) * DM + (mixB ? 768 : 0) + head * 128);
#pragma unroll
      for (int i = 0; i < 8; ++i) { const int row = (ln >> 4) + 4 * i; const v4u w = *(const LAS v4u*)(ost + row * OST_PITCH + (ln & 15) * 16);
          *(v4u*)(Ow + (size_t)row * DM * 2 + (ln & 15) * 16) = w; } }
    __syncthreads();
}
#undef LAUNDER
#undef KSWZ
#undef SBAR

constexpr int GT_PITCH = 136;
__device__ __forceinline__ void gmlp_unit(const Args& a, int l, int unit, LAS unsigned char* lds, int tid, int wave, int lane) {
    const int n = unit >> 2, g = unit & 3, R0 = n * 128;
    const bf16* Z = (const bf16*)(a.ws + WS_Z); bf16* MR = (bf16*)(a.ws + WS_MRG);
    LAS unsigned short* T = (LAS unsigned short*)lds;
    LAS float* ST = (LAS float*)(lds + 128 * GT_PITCH * 2);
    const int fi = lane & 15, kg = lane >> 4, p = wave * 16 + fi;
    bf16x8 wf[4];
    { const float* W = a.in[I_GW] + (size_t)((l * 4 + g) * 128 + p) * 128 + 8 * kg;
#pragma unroll
      for (int ks = 0; ks < 4; ++ks) { const f32x4 x0 = *(const f32x4*)(W + 32 * ks), x1 = *(const f32x4*)(W + 32 * ks + 4);
          v4u w; w.x = att::cvtpk(x0[0], x0[1]); w.y = att::cvtpk(x0[2], x0[3]); w.z = att::cvtpk(x1[0], x1[1]); w.w = att::cvtpk(x1[2], x1[3]); wf[ks] = __builtin_bit_cast(bf16x8, w); } }
    { const int q = tid >> 2, cp = tid & 3; const bf16* zp = Z + (size_t)(R0 + q) * INW + VC_ + cp * 8; v4u vw[16];
#pragma unroll
      for (int i = 0; i < 16; ++i) vw[i] = *(const v4u*)(zp + i * 32);
      float s = 0.f, s2 = 0.f;
#pragma unroll
      for (int i = 0; i < 16; ++i) { const v4u w = vw[i]; const float v[8] = {bflo(w.x), bfhi(w.x), bflo(w.y), bfhi(w.y), bflo(w.z), bfhi(w.z), bflo(w.w), bfhi(w.w)};
#pragma unroll
          for (int e = 0; e < 8; ++e) { s += v[e]; s2 += v[e] * v[e]; } }
      s += __shfl_xor(s, 1); s2 += __shfl_xor(s2, 1); s += __shfl_xor(s, 2); s2 += __shfl_xor(s2, 2);
      const float mean = s * (1.0f / 512.0f), var = s2 * (1.0f / 512.0f) - mean * mean;
      if (cp == 0) { ST[q * 2] = mean; ST[q * 2 + 1] = rsqrtf(var + NORM_EPS); } }
    __syncthreads();
    { const int q = tid >> 2, cp = tid & 3; const float mean = ST[q * 2], rstd = ST[q * 2 + 1];
      const bf16* zp = Z + (size_t)(R0 + q) * INW + VC_ + g * 128 + cp * 32; const float* lg = a.in[I_LNG] + l * 512 + g * 128 + cp * 32; const float* lb = a.in[I_LNB] + l * 512 + g * 128 + cp * 32;
#pragma unroll
      for (int c8 = 0; c8 < 4; ++c8) { const v4u w = *(const v4u*)(zp + c8 * 8);
          const float v[8] = {bflo(w.x), bfhi(w.x), bflo(w.y), bfhi(w.y), bflo(w.z), bfhi(w.z), bflo(w.w), bfhi(w.w)};
#pragma unroll
          for (int e = 0; e < 8; ++e) { const int c = cp * 32 + c8 * 8 + e; const float y = (v[e] - mean) * rstd * lg[c8 * 8 + e] + lb[c8 * 8 + e]; T[c * GT_PITCH + q] = (unsigned short)f2bf(y); } } }
    __syncthreads();
    f32x4 acc[8];
#pragma unroll
    for (int cb = 0; cb < 8; ++cb) acc[cb] = (f32x4){0.f, 0.f, 0.f, 0.f};
#pragma unroll
    for (int cb = 0; cb < 8; ++cb)
#pragma unroll
        for (int ks = 0; ks < 4; ++ks) { const bf16x8 af = *(const LAS bf16x8*)(T + (cb * 16 + fi) * GT_PITCH + 32 * ks + 8 * kg);
            acc[cb] = __builtin_amdgcn_mfma_f32_16x16x32_bf16(af, wf[ks], acc[cb], 0, 0, 0); }
    const float bs = a.in[I_GB][(l * 4 + g) * 128 + p];
#pragma unroll
    for (int cb = 0; cb < 8; ++cb) { const int ch = g * 128 + cb * 16 + 4 * kg; const v2u uw = *(const v2u*)(Z + (size_t)(R0 + p) * INW + UC_ + ch);
        v2u ow; ow.x = att::cvtpk(bflo(uw.x) * (acc[cb][0] + bs), bfhi(uw.x) * (acc[cb][1] + bs)); ow.y = att::cvtpk(bflo(uw.y) * (acc[cb][2] + bs), bfhi(uw.y) * (acc[cb][3] + bs));
        *(v2u*)(MR + (size_t)(R0 + p) * DM + 1536 + ch) = ow; }
    __syncthreads();
}
}
constexpr int N_PHASES = 2 + 7 * DEPTH;
#ifndef MK_SP2
#define MK_SP2 true
#endif
#ifndef MK_ALIGN
#define MK_ALIGN true
#endif
#ifndef MK_REP_T0
#define MK_REP_T0 1
#endif
#ifndef MK_REP_P0
#define MK_REP_P0 1
#endif
#ifndef MK_REP_G1
#define MK_REP_G1 1
#endif
#ifndef MK_REP_MIX
#define MK_REP_MIX 1
#endif
#ifndef MK_REP_G2
#define MK_REP_G2 1
#endif
#ifndef MK_REP_G3
#define MK_REP_G3 1
#endif
#ifndef MK_REP_G4
#define MK_REP_G4 1
#endif
__global__ void __launch_bounds__(NWAVES * 64, 2) fwd_kernel(Args args) {
    extern __shared__ __attribute__((aligned(16))) unsigned char lds_raw[];
    LAS unsigned char* lds = (LAS unsigned char*)lds_raw;
    volatile LAS unsigned* MISC = (volatile LAS unsigned*)(lds + MISC_OFF);
    const int tid = threadIdx.x, G = gridDim.x; const int wave_s = __builtin_amdgcn_readfirstlane(tid >> 6);
    unsigned* ctl = (unsigned*)(args.ws + WS_CTL);
    for (int u = tid; u < (LDS_BYTES - LDSCTL_OFF) / 4; u += NWAVES * 64) ((LAS unsigned*)(lds + LDSCTL_OFF))[u] = 0u;
    __syncthreads();
    XcdBarrier bar = xcd_barrier_post(ctl + CW_BAR, MISC + 8);
    const int lo = args.ph_lo, hi = args.ph_hi;
#define IN(k) (lo <= (k) && (k) < hi)
#define PHASE_IDS() int lane_p = (int)__builtin_amdgcn_mbcnt_hi(~0u, __builtin_amdgcn_mbcnt_lo(~0u, 0u)); asm volatile("" : "+v"(lane_p)); const int wave_p = wave_s, tid_p = wave_s * 64 + lane_p; (void)tid_p; (void)wave_p
#ifndef MK_WGM_G2
#define MK_WGM_G2 4
#endif
#ifndef MK_CONV_FIRST
#define MK_CONV_FIRST 1
#endif
#ifndef MK_WGM_G4
#define MK_WGM_G4 4
#endif
#ifndef MK_WS_TOP
#define MK_WS_TOP 1
#endif
#ifndef MK_REP_SEAM
#define MK_REP_SEAM 0
#endif
#ifndef MK_REP_BAR
#define MK_REP_BAR 1
#endif
#define SEAM(k) do { if ((k) + 1 < hi) { for (int rb_ = 0; rb_ < MK_REP_BAR; ++rb_) xcd_barrier(bar); } } while (0)

    if (IN(0)) { for (int rep = 0; rep < MK_REP_P0; ++rep) { PHASE_IDS(); p0_prologue(args, lds, tid_p, wave_p, lane_p, G); __syncthreads(); } SEAM(0); }
    if (IN(1)) { for (int rep = 0; rep < MK_REP_T0; ++rep) { PHASE_IDS(); thin_phase<0, true>(args, lds, tid_p, wave_p, lane_p, G, nullptr, 0, 0, args.in[I_NMPRE], 1, 0, 0); } SEAM(1); }

    for (int l = 0; l < DEPTH; ++l) {
        const int pb = 2 + 7 * l;
        if (IN(pb + 0)) {
            pg8::Gemm g{(const pg8::bf16_t*)(args.ws + WS_H), (const pg8::bf16_t*)(args.ws + WS_WIN) + (size_t)l * INW * DM, MROWS, INW, DM};
            pg8::StaticOrder S; S.init(MROWS, INW, G, (int)blockIdx.x);
            pg8::EpiWin E{(pg8::bf16_t*)(args.ws + WS_Z), args.out, l};
#if MK_CONV_FIRST
            { constexpr int total = (MROWS / 256) * (INW / 256); const int rounds = (total + G - 1) / G, nshort = rounds * G - total, c = (int)blockIdx.x;
              if (nshort == 0 || c >= G - nshort) { PHASE_IDS(); const int ns = nshort == 0 ? G : nshort, cc = nshort == 0 ? c : c - (G - nshort);
#if MK_CONV_SAMELAYER
                  p0_convert_items(args, l, lds, wave_p, lane_p, cc * NWAVES + wave_p, ns * NWAVES, CONV_I_IN, CONV_PER_L);
                  if (l + 1 < DEPTH) p0_convert_items(args, l + 1, lds, wave_p, lane_p, cc * NWAVES + wave_p, ns * NWAVES, 0, CONV_I_IN);
#else
                  if (l + 1 < DEPTH) p0_convert_items(args, l + 1, lds, wave_p, lane_p, cc * NWAVES + wave_p, ns * NWAVES, 0, CONV_PER_L);
#endif
                  __syncthreads(); } }
            for (int rep = 0; rep < MK_REP_G1; ++rep)
            pg8::gemm_phase<pg8::EpiWin, pg8::StaticOrder, MK_ALIGN, MK_SP2>(lds + RING_OFF, g, S, E, wave_s);
#else
            for (int rep = 0; rep < MK_REP_G1; ++rep)
            pg8::gemm_phase<pg8::EpiWin, pg8::StaticOrder, MK_ALIGN, MK_SP2>(lds + RING_OFF, g, S, E, wave_s);
            if (MK_CONV_TAIL && l + 1 < DEPTH) { constexpr int total = (MROWS / 256) * (INW / 256); const int rounds = (total + G - 1) / G, nshort = rounds * G - total, c = (int)blockIdx.x;
                if (nshort == 0) { PHASE_IDS(); p0_convert_layer(args, l + 1, lds, wave_p, lane_p, MK_CONV_ADJ ? c * NWAVES + wave_p : wave_p * G + c, G * NWAVES, 0, MK_CONV_TAIL); }
                else if (c >= G - nshort) { PHASE_IDS(); p0_convert_layer(args, l + 1, lds, wave_p, lane_p, MK_CONV_ADJ ? (c - (G - nshort)) * NWAVES + wave_p : wave_p * nshort + (c - (G - nshort)), nshort * NWAVES, 0, MK_CONV_TAIL); } }
#endif
            SEAM(pb + 0);
        }
        if (IN(pb + 1)) {
            PHASE_IDS();
            for (int rep = 0; rep < MK_REP_MIX; ++rep) {
                unsigned* qctr = ctl + CW_QUEUE + 64 * (l + 4 * rep); volatile LAS unsigned* qw = MISC + 16;
                unsigned tk = 0;
                if (tid_p == 0) qw[0] = __hip_atomic_fetch_add(qctr, 1u, __ATOMIC_RELAXED, __HIP_MEMORY_SCOPE_AGENT);
                __syncthreads(); tk = (unsigned)__builtin_amdgcn_readfirstlane((int)qw[0]); __syncthreads();
                while (tk < (unsigned)att::N_UNITS) {
                    unsigned nx = 0; if (tid_p == 0) nx = __hip_atomic_fetch_add(qctr, 1u, __ATOMIC_RELAXED, __HIP_MEMORY_SCOPE_AGENT);
                    att::attn_unit(args, l, (int)tk, lds + RING_OFF, wave_p, lane_p);
                    if (tid_p == 0) qw[0] = nx;
                    __syncthreads(); tk = (unsigned)__builtin_amdgcn_readfirstlane((int)qw[0]); __syncthreads();
                }
                while (tk < (unsigned)(att::N_UNITS + att::N_GMLP)) {
                    unsigned nx = 0; if (tid_p == 0) nx = __hip_atomic_fetch_add(qctr, 1u, __ATOMIC_RELAXED, __HIP_MEMORY_SCOPE_AGENT);
                    att::gmlp_unit(args, l, (int)tk - att::N_UNITS, lds + RING_OFF, tid_p, wave_p, lane_p);
                    if (tid_p == 0) qw[0] = nx;
                    __syncthreads(); tk = (unsigned)__builtin_amdgcn_readfirstlane((int)qw[0]); __syncthreads();
                }
            }
            SEAM(pb + 1);
        }
        if (IN(pb + 2)) {
            pg8::Gemm g{(const pg8::bf16_t*)(args.ws + WS_MRG), (const pg8::bf16_t*)(args.ws + WS_WOUT) + (size_t)l * DM * DM, MROWS, DM, DM};
            pg8::StaticOrder S; S.init(MROWS, DM, G, (int)blockIdx.x, MK_WGM_G2);
            pg8::EpiBf16 E{(pg8::bf16_t*)(args.ws + WS_F1), DM};
            for (int rep = 0; rep < MK_REP_G2; ++rep) {
            pg8::gemm_phase<pg8::EpiBf16, pg8::StaticOrder, MK_ALIGN, MK_SP2>(lds + RING_OFF, g, S, E, wave_s);
            if (MK_REP_SEAM && rep + 1 < MK_REP_G2) xcd_barrier(bar); }
            SEAM(pb + 2);
        }
        if (IN(pb + 3)) {
            PHASE_IDS(); thin_phase<1, true>(args, lds, tid_p, wave_p, lane_p, G, args.in[I_NMPOST] + l * DM, 2, l, args.in[I_NFPRE] + l * DM, 4, 3, l);
            SEAM(pb + 3);
        }
        if (IN(pb + 4)) {
            pg8::Gemm g{(const pg8::bf16_t*)(args.ws + WS_H), (const pg8::bf16_t*)(args.ws + WS_WGU) + (size_t)l * NGU * DM, MROWS, NGU, DM};
            pg8::StaticOrder S; S.init(MROWS, NGU, G, (int)blockIdx.x);
            pg8::EpiGU E{(pg8::bf16_t*)(args.ws + WS_ACT)};
            for (int rep = 0; rep < MK_REP_G3; ++rep)
            pg8::gemm_phase<pg8::EpiGU, pg8::StaticOrder, MK_ALIGN, MK_SP2>(lds + RING_OFF, g, S, E, wave_s);
            SEAM(pb + 4);
        }
        if (IN(pb + 5)) {
            pg8::Gemm g{(const pg8::bf16_t*)(args.ws + WS_ACT), (const pg8::bf16_t*)(args.ws + WS_WDN) + (size_t)l * DM * DFF, MROWS, DM, DFF};
            pg8::StaticOrder S; S.init(MROWS, DM, G, (int)blockIdx.x, MK_WGM_G4);
            pg8::EpiBf16 E{(pg8::bf16_t*)(args.ws + WS_F2), DM};
            for (int rep = 0; rep < MK_REP_G4; ++rep)
            pg8::gemm_phase<pg8::EpiBf16, pg8::StaticOrder, MK_ALIGN, MK_SP2>(lds + RING_OFF, g, S, E, wave_s);
            SEAM(pb + 5);
        }
        if (IN(pb + 6)) {
            PHASE_IDS();
            if (l + 1 < DEPTH) thin_phase<1, true>(args, lds, tid_p, wave_p, lane_p, G, args.in[I_NFPOST] + l * DM, 5, l, args.in[I_NMPRE] + (l + 1) * DM, 1, 0, l + 1);
            else thin_phase<1, false>(args, lds, tid_p, wave_p, lane_p, G, args.in[I_NFPOST] + l * DM, 5, l, nullptr, 0, 0, 0);
            SEAM(pb + 6);
        }
    }
#undef IN
#undef SEAM
}

#ifndef MK_LAUNCH_MODE
#define MK_LAUNCH_MODE 0
#endif
extern "C" void kernel_launch(void* const* d_in, const int* in_sizes, int n_in, void* d_out, int out_size, void* d_ws, size_t ws_size, hipStream_t stream) {
    static int grid = 0;
    if (grid == 0) {
        if (n_in != N_IN || (size_t)out_size != O_END || ws_size < WS_END) { fprintf(stderr, "kernel_launch: unexpected shapes: n_in %d out %d ws %zu\n", n_in, out_size, ws_size); grid = -1; return; }
        int dev = 0, cus = 0, per_cu = 0;
        if (hipGetDevice(&dev) != hipSuccess || hipDeviceGetAttribute(&cus, hipDeviceAttributeMultiprocessorCount, dev) != hipSuccess) { fprintf(stderr, "kernel_launch: device query failed\n"); grid = -1; return; }
        if (hipFuncSetAttribute((const void*)fwd_kernel, hipFuncAttributeMaxDynamicSharedMemorySize, LDS_BYTES) != hipSuccess) { fprintf(stderr, "kernel_launch: hipFuncSetAttribute failed\n"); grid = -1; return; }
        if (hipOccupancyMaxActiveBlocksPerMultiprocessor(&per_cu, (const void*)fwd_kernel, NWAVES * 64, LDS_BYTES) != hipSuccess || per_cu < 1)
            fprintf(stderr, "kernel_launch: note: occupancy query reports %d workgroups per CU\n", per_cu);
        (void)hipGetLastError();
        grid = cus;
    }
    if (grid < 0) return;
    const size_t ws_shift = MK_WS_TOP ? ((ws_size - WS_END) & ~(size_t)(2 * MiB - 1)) : 0;
    if (hipMemsetAsync((char*)d_ws + ws_shift + WS_CTL, 0, CTL_ZERO_BYTES, stream) != hipSuccess) { fprintf(stderr, "kernel_launch: memset failed\n"); return; }
    Args a{};
    for (int i = 0; i < N_IN; ++i) a.in[i] = (const float*)d_in[i];
    a.out = (float*)d_out; a.ws = (unsigned char*)d_ws + ws_shift;
#if MK_LAUNCH_MODE == 1
    a.ph_lo = 0; a.ph_hi = N_PHASES;
    hipLaunchKernelGGL(fwd_kernel, dim3(grid), dim3(NWAVES * 64), LDS_BYTES, stream, a);
#else
    for (int p = 0; p < N_PHASES; ++p) { a.ph_lo = p; a.ph_hi = p + 1;
        hipLaunchKernelGGL(fwd_kernel, dim3(grid), dim3(NWAVES * 64), LDS_BYTES, stream, a); }
#endif
    const hipError_t le = hipPeekAtLastError();
    if (le != hipSuccess) fprintf(stderr, "kernel_launch: launch failed: %s\n", hipGetErrorName(le));
}
```
